# Optimizing an MI355X kernel written in HIP

```python
import math
import jax, jax.numpy as jnp
from jax import lax
import numpy as np

D_MODEL = 1024
BATCH = 2
SEQ = 8192
DEPTH = 1

HG_HEADS = 4
HG_DIM = 128
HG_WIDTH = HG_HEADS * HG_DIM
CHUNK = 64
ATT_Q_HEADS = 8
ATT_KV_HEADS = 2
ATT_HEAD_DIM = 64
ATT_GROUP = ATT_Q_HEADS // ATT_KV_HEADS
ATT_WIDTH = ATT_Q_HEADS * ATT_HEAD_DIM
KV_WIDTH = ATT_KV_HEADS * ATT_HEAD_DIM
WINDOW = 128
BLOCK = 128
NUM_BUCKETS = 32
MAX_DISTANCE = 128
D_FF = 2816
N_MOD = 9
EPS = 1e-6
MIX_WIDTH = HG_WIDTH + ATT_WIDTH
IN_SPLITS = (HG_WIDTH, HG_WIDTH, HG_WIDTH, HG_WIDTH, HG_WIDTH, ATT_WIDTH, KV_WIDTH, KV_WIDTH)
D_IN = sum(IN_SPLITS)

kernel_name = "hybrid_hgrn2_swa_macaron_encoder"


def rmsnorm(x, g):
    x32 = x.astype(jnp.float32)
    y = x32 * lax.rsqrt(jnp.mean(x32 * x32, axis=-1, keepdims=True) + EPS)
    return (y * g.astype(jnp.float32)).astype(x.dtype)


def modulate(h, shift, scale):
    return h * (1.0 + scale[:, None, :]) + shift[:, None, :]


def swiglu(h, w_in, w_out):
    gate, up = jnp.split(h @ w_in, 2, axis=-1)
    return (jax.nn.silu(gate) * up) @ w_out


def split_columns(z):
    outs, off = [], 0
    for n in IN_SPLITS:
        outs.append(z[..., off:off + n])
        off += n
    return outs


def t5_bucket(rel):
    nb = NUM_BUCKETS // 2
    max_exact = nb // 2
    ret = (rel > 0).astype(jnp.int32) * nb
    n = jnp.abs(rel)
    large = max_exact + (jnp.log(jnp.maximum(n, 1).astype(jnp.float32) / max_exact)
                         / math.log(MAX_DISTANCE / max_exact) * (nb - max_exact)).astype(jnp.int32)
    large = jnp.minimum(large, nb - 1)
    return ret + jnp.where(n < max_exact, n, large)


def hgrn2_direction(q, k, v, g):
    B, H, S, DK = q.shape
    DV = v.shape[-1]
    n = S // CHUNK

    def to_chunks(t):
        return jnp.moveaxis(t.reshape(B, H, n, CHUNK, t.shape[-1]), 2, 0)

    causal = jnp.tril(jnp.ones((CHUNK, CHUNK), dtype=bool))[:, :, None]

    def step(state, inp):
        q_c, k_c, v_c, g_c = inp
        G = jnp.cumsum(g_c, axis=2)
        o_inter = jnp.einsum('bhtd,bhde->bhte', q_c * jnp.exp(G), state)
        diff = G[:, :, :, None, :] - G[:, :, None, :, :]
        decay = jnp.where(causal, jnp.exp(jnp.where(causal, diff, 0.0)), 0.0)
        A = jnp.einsum('bhtd,bhsd,bhtsd->bhts', q_c, k_c, decay)
        o_intra = jnp.einsum('bhts,bhse->bhte', A, v_c)
        G_last = G[:, :, -1:, :]
        k_dec = k_c * jnp.exp(G_last - G)
        new_state = jnp.exp(G_last[:, :, 0, :])[..., None] * state + jnp.einsum('bhsd,bhse->bhde', k_dec, v_c)
        return new_state, o_inter + o_intra

    s0 = jnp.zeros((B, H, DK, DV), jnp.float32)
    _, o = lax.scan(step, s0, (to_chunks(q), to_chunks(k), to_chunks(v), to_chunks(g)))
    return jnp.moveaxis(o, 0, 2).reshape(B, H, S, DV)


def hgrn2_group(q_raw, ff_raw, fb_raw, i_raw, g_raw, lb, norm_g):
    B, S, _ = q_raw.shape

    def heads(t):
        return t.astype(jnp.float32).reshape(B, S, HG_HEADS, HG_DIM).transpose(0, 2, 1, 3)

    q = heads(jax.nn.silu(q_raw))
    v = heads(i_raw)
    lb = lb.astype(jnp.float32)
    outs = []
    for d, f_raw in enumerate((ff_raw, fb_raw)):
        fr = heads(f_raw)
        lb_d = lb[d].reshape(1, HG_HEADS, 1, HG_DIM)
        log_f = jnp.logaddexp(jnp.log(lb_d), jnp.log1p(-lb_d) + jax.nn.log_sigmoid(fr))
        k = (1.0 - lb_d) * jax.nn.sigmoid(-fr)
        if d == 0:
            outs.append(hgrn2_direction(q, k, v, log_f))
        else:
            flip = lambda t: jnp.flip(t, axis=2)
            outs.append(flip(hgrn2_direction(flip(q), flip(k), flip(v), flip(log_f))))
    o = (outs[0] + outs[1]).transpose(0, 2, 1, 3)
    o = o * lax.rsqrt(jnp.mean(o * o, axis=-1, keepdims=True) + EPS)
    o = o.reshape(B, S, HG_WIDTH) * norm_g.astype(jnp.float32)
    return (o * jax.nn.silu(g_raw.astype(jnp.float32))).astype(q_raw.dtype)


def windowed_gqa(q_raw, k_raw, v_raw, q_g, k_g, sink, rel_bias):
    B, S, _ = q_raw.shape
    nb = S // BLOCK
    q = rmsnorm(q_raw.reshape(B, S, ATT_Q_HEADS, ATT_HEAD_DIM), q_g)
    k = rmsnorm(k_raw.reshape(B, S, ATT_KV_HEADS, ATT_HEAD_DIM), k_g)
    v = v_raw.reshape(B, S, ATT_KV_HEADS, ATT_HEAD_DIM)
    qb = q.reshape(B, nb, BLOCK, ATT_KV_HEADS, ATT_GROUP, ATT_HEAD_DIM)

    def band(t):
        tp = jnp.pad(t, ((0, 0), (BLOCK, BLOCK), (0, 0), (0, 0))).reshape(B, nb + 2, BLOCK, ATT_KV_HEADS, ATT_HEAD_DIM)
        return jnp.concatenate([tp[:, :-2], tp[:, 1:-1], tp[:, 2:]], axis=2)

    kw, vw = band(k), band(v)
    logits = jnp.einsum('bnqhgd,bnkhd->bnhgqk', qb, kw).astype(jnp.float32) / math.sqrt(ATT_HEAD_DIM)
    rel = (jnp.arange(3 * BLOCK)[None, :] - BLOCK) - jnp.arange(BLOCK)[:, None]
    bias = rel_bias.astype(jnp.float32)[t5_bucket(rel)]
    bias = bias.reshape(BLOCK, 3 * BLOCK, ATT_KV_HEADS, ATT_GROUP).transpose(2, 3, 0, 1)
    key_pos = jnp.arange(nb)[:, None] * BLOCK + jnp.arange(3 * BLOCK)[None, :] - BLOCK
    valid = (jnp.abs(rel) <= WINDOW)[None] & ((key_pos >= 0) & (key_pos < S))[:, None, :]
    logits = jnp.where(valid[None, :, None, None], logits + bias, -jnp.inf)
    sink_b = sink.astype(jnp.float32).reshape(ATT_KV_HEADS, ATT_GROUP, 1, 1)
    m = jnp.maximum(jnp.max(logits, axis=-1, keepdims=True), sink_b)
    p = jnp.exp(logits - m)
    p = p / (jnp.sum(p, axis=-1, keepdims=True) + jnp.exp(sink_b - m))
    o = jnp.einsum('bnhgqk,bnkhd->bnqhgd', p.astype(vw.dtype), vw)
    return o.reshape(B, S, ATT_WIDTH)


def setup_inputs(seed: int = 0) -> dict:
    key = jax.random.key(seed)
    ks = jax.random.split(key, 16)
    L, D, F = DEPTH, D_MODEL, D_FF
    nrm = jax.random.normal
    return {
        "x": nrm(ks[0], (BATCH, SEQ, D), jnp.float32),
        "c": nrm(ks[1], (BATCH, D), jnp.float32),
        "w_ada": nrm(ks[2], (L, D, N_MOD * D), jnp.float32) * 0.02,
        "b_ada": nrm(ks[3], (L, N_MOD * D), jnp.float32) * 0.02,
        "norm_g": 1.0 + 0.02 * nrm(ks[4], (L, 3, D), jnp.float32),
        "w_ffn1_in": nrm(ks[5], (L, D, 2 * F), jnp.float32) * D ** -0.5,
        "w_ffn1_out": nrm(ks[6], (L, F, D), jnp.float32) * F ** -0.5,
        "w_ffn2_in": nrm(ks[7], (L, D, 2 * F), jnp.float32) * D ** -0.5,
        "w_ffn2_out": nrm(ks[8], (L, F, D), jnp.float32) * F ** -0.5,
        "w_mix_in": nrm(ks[9], (L, D, D_IN), jnp.float32) * D ** -0.5,
        "w_mix_out": nrm(ks[10], (L, MIX_WIDTH, D), jnp.float32) * MIX_WIDTH ** -0.5,
        "hgrn_lb": nrm(ks[11], (2, L + 1, HG_WIDTH), jnp.float32),
        "hgrn_norm_g": 1.0 + 0.02 * nrm(ks[12], (L, HG_WIDTH), jnp.float32),
        "qk_norm_g": 1.0 + 0.02 * nrm(ks[13], (L, 2, ATT_HEAD_DIM), jnp.float32),
        "attn_sink": 0.5 * nrm(ks[14], (L, ATT_Q_HEADS), jnp.float32),
        "rel_bias": 0.5 * nrm(ks[15], (NUM_BUCKETS, ATT_Q_HEADS), jnp.float32),
    }


def reference(x, c, w_ada, b_ada, norm_g, w_ffn1_in, w_ffn1_out, w_ffn2_in, w_ffn2_out,
              w_mix_in, w_mix_out, hgrn_lb, hgrn_norm_g, qk_norm_g, attn_sink, rel_bias):
    lb_all = jnp.cumsum(jax.nn.softmax(hgrn_lb.astype(jnp.float32), axis=1), axis=1)
    c_act = jax.nn.silu(c)
    for l in range(DEPTH):
        mods = jnp.split(c_act @ w_ada[l] + b_ada[l], N_MOD, axis=-1)
        sh1, sc1, g1, sh2, sc2, g2, sh3, sc3, g3 = mods
        h = modulate(rmsnorm(x, norm_g[l, 0]), sh1, sc1)
        x = x + 0.5 * g1[:, None, :] * swiglu(h, w_ffn1_in[l], w_ffn1_out[l])
        h = modulate(rmsnorm(x, norm_g[l, 1]), sh2, sc2)
        hq, hf_f, hf_b, hi, hg, aq, ak, av = split_columns(h @ w_mix_in[l])
        o_hgrn = hgrn2_group(hq, hf_f, hf_b, hi, hg, lb_all[:, l], hgrn_norm_g[l])
        o_attn = windowed_gqa(aq, ak, av, qk_norm_g[l, 0], qk_norm_g[l, 1], attn_sink[l], rel_bias)
        mixed = jnp.concatenate([o_hgrn, o_attn.astype(o_hgrn.dtype)], axis=-1) @ w_mix_out[l]
        x = x + g2[:, None, :] * mixed
        h = modulate(rmsnorm(x, norm_g[l, 2]), sh3, sc3)
        x = x + 0.5 * g3[:, None, :] * swiglu(h, w_ffn2_in[l], w_ffn2_out[l])
    return x
```

```cpp
#include <hip/hip_runtime.h>
#include <cstdio>
#include <cstdint>
#include <hip/hip_bf16.h>
namespace pg8 {
#define PG8_LAS __attribute__((address_space(3)))
typedef unsigned short bf16_t;
typedef short bf16x8 __attribute__((ext_vector_type(8)));
typedef float f32x4 __attribute__((ext_vector_type(4)));
typedef unsigned u32x4 __attribute__((ext_vector_type(4)));
constexpr int BM = 256, BK = 64, HALF = 128, HTB = HALF * BK * 2  , STAGE_BYTES = 8 * HTB, NXCD = 8, WGM = 8;

__host__ __device__ __forceinline__ int lds_byte(int r, int c) { const int st = (r >> 4) * 2 + (c >> 5), rr = r & 15, cc = c & 31, ob = rr * 64 + cc * 2; return st * 1024 + (ob ^ (((ob >> 9) & 1) << 5)); }
__host__ __device__ __forceinline__ void stage_rc(int b, int& R, int& C) { const int st = b / 1024, sb = b % 1024, swz = sb ^ (((sb >> 9) & 1) << 5); R = (st >> 1) * 16 + swz / 64; C = (st & 1) * 32 + (swz % 64) / 2; }
__host__ __device__ __forceinline__ int perm32(int rho) { const int n = rho >> 4, i = rho & 15; return 8 * (i >> 2) + 4 * n + (i & 3); }

struct Unit { int pm, pn; };
struct Gemm { const bf16_t* A; const bf16_t* Bt; int M, N, K; };

struct StaticOrder {
    int nM, nN, nwg, G, c;
    __host__ __device__ void init(int M, int N, int G_, int c_) { nM = M / BM; nN = N / BM; nwg = nM * nN; G = G_; c = c_; }
    __host__ __device__ bool next(int i, Unit& u) const {
        const long L = (long)i * G + c; if (L >= nwg) return false;
        int wgid = (int)L; { const int q = nwg / NXCD, r = nwg % NXCD, xcd = wgid % NXCD, off = wgid / NXCD; wgid = (xcd < r ? xcd * (q + 1) : r * (q + 1) + (xcd - r) * q) + off; }
        const int nig = WGM * nN, gid = wgid / nig, fm = gid * WGM, gsz = (nM - fm) < WGM ? (nM - fm) : WGM;
        u.pm = fm + ((wgid % nig) % gsz); u.pn = (wgid % nig) / gsz; return true;
    }
    __device__ __forceinline__ void a_ready(const Unit&) const {}
    __device__ __forceinline__ void done(const Unit&) const {}
};

__device__ __forceinline__ unsigned cvt_pk_bf16(float lo, float hi) { unsigned r; asm volatile("v_cvt_pk_bf16_f32 %0, %1, %2" : "=v"(r) : "v"(lo), "v"(hi)); return r; }
typedef float f32x2 __attribute__((ext_vector_type(2)));
__device__ __forceinline__ float sigmoid_f(float x) { return __builtin_amdgcn_rcpf(1.0f + __builtin_amdgcn_exp2f(-1.4426950408889634f * x)); }
__device__ __forceinline__ float silu_f(float x) { return x * sigmoid_f(x); }
struct EpiSwiGLU {
    static constexpr bool PERM = true, AFTER_DRAIN = false;
    bf16_t* O; int ldc;
    __device__ __forceinline__ void operator()(const f32x4 (&acc)[2][2][4][2], const Unit& u, int wr, int wc, int fr, int fq) const {
        const int row0 = u.pm * BM + wr * 64 + fr, col0 = u.pn * HALF + wc * 32 + 8 * fq;
#pragma unroll
        for (int ai = 0; ai < 2; ++ai)
#pragma unroll
            for (int m = 0; m < 4; ++m) { bf16_t* rowp = O + (size_t)(row0 + ai * HALF + m * 16) * ldc + col0;
                float h[8];
#pragma unroll
                for (int n = 0; n < 2; ++n)
#pragma unroll
                    for (int j = 0; j < 4; ++j) h[n * 4 + j] = silu_f(acc[ai][0][m][n][j]) * acc[ai][1][m][n][j];
                u32x4 w; w.x = cvt_pk_bf16(h[0], h[1]); w.y = cvt_pk_bf16(h[2], h[3]); w.z = cvt_pk_bf16(h[4], h[5]); w.w = cvt_pk_bf16(h[6], h[7]);
                *(u32x4*)rowp = w; }
    }
};
struct EpiResid {
    static constexpr bool PERM = false, AFTER_DRAIN = false;
    const float* base; float* out; const float* gate; int gstride; float sc;
    __device__ __forceinline__ void operator()(const f32x4 (&acc)[2][2][4][2], const Unit& u, int wr, int wc, int fr, int fq) const {
        const int row0 = u.pm * BM + wr * 64 + fr, col0 = u.pn * BM + wc * 32 + 4 * fq;
        const float* gp = gate + (size_t)(u.pm >= 32 ? gstride : 0) + col0;
        f32x4 gv[2][2];
#pragma unroll
        for (int bj = 0; bj < 2; ++bj)
#pragma unroll
            for (int n = 0; n < 2; ++n) gv[bj][n] = *(const f32x4*)(gp + bj * HALF + n * 16) * sc;
#pragma unroll
        for (int ai = 0; ai < 2; ++ai)
#pragma unroll
            for (int m = 0; m < 4; ++m) { const size_t off = (size_t)(row0 + ai * HALF + m * 16) * 1024 + col0;
#pragma unroll
                for (int bj = 0; bj < 2; ++bj)
#pragma unroll
                    for (int n = 0; n < 2; ++n) { const f32x4 bs = *(const f32x4*)(base + off + bj * HALF + n * 16);
                        *(f32x4*)(out + off + bj * HALF + n * 16) = bs + gv[bj][n] * acc[ai][bj][m][n]; } }
    }
};
struct EpiMixIn {
    static constexpr bool PERM = true, AFTER_DRAIN = false;
    bf16_t* O; const float* lb;
    __device__ __forceinline__ void operator()(const f32x4 (&acc)[2][2][4][2], const Unit& u, int wr, int wc, int fr, int fq) const {
        const int row0 = u.pm * BM + wr * 64 + fr, col0 = u.pn * BM + wc * 32 + 8 * fq;
        const int kind = (u.pn < 2) ? 1 : (u.pn < 6) ? 2 : (u.pn < 8) ? 0 : (u.pn < 10) ? 1 : 0;
        float oml[2][8];
#pragma unroll
        for (int bj = 0; bj < 2; ++bj)
#pragma unroll
            for (int j = 0; j < 8; ++j) oml[bj][j] = (kind == 2) ? 1.0f - lb[col0 + bj * HALF + j - 512] : 0.f;
#pragma unroll
        for (int ai = 0; ai < 2; ++ai)
#pragma unroll
            for (int m = 0; m < 4; ++m) { bf16_t* rowp = O + (size_t)(row0 + ai * HALF + m * 16) * 3328 + col0;
#pragma unroll
                for (int bj = 0; bj < 2; ++bj) { float h[8];
#pragma unroll
                    for (int n = 0; n < 2; ++n)
#pragma unroll
                        for (int j = 0; j < 4; ++j) { const float z = acc[ai][bj][m][n][j]; float r = z;
                            if (kind == 1) r = silu_f(z);
                            else if (kind == 2) { const float k = oml[bj][n * 4 + j] * sigmoid_f(-z); r = __builtin_amdgcn_logf(1.0f - k) * 0.6931471805599453f; }
                            h[n * 4 + j] = r; }
                    u32x4 w; w.x = cvt_pk_bf16(h[0], h[1]); w.y = cvt_pk_bf16(h[2], h[3]); w.z = cvt_pk_bf16(h[4], h[5]); w.w = cvt_pk_bf16(h[6], h[7]);
                    *(u32x4*)(rowp + bj * HALF) = w; } }
    }
};
template <class Epi, class Sched, bool ALIGN_EPI = false, bool SP2 = false>
__device__ __forceinline__ void gemm_phase(PG8_LAS unsigned char* lds, const Gemm g, const Sched& S, const Epi& E) {
    const int tid = threadIdx.x, wid = __builtin_amdgcn_readfirstlane(tid >> 6), lane = tid & 63, wr = wid >> 2, wc = wid & 3, fr = lane & 15, fq = lane >> 4;
    const int K = g.K, nt = K / BK;
    unsigned voffA[2], voffB[2];
#pragma unroll
    for (int i = 0; i < 2; ++i) { int R, C; stage_rc(tid * 16 + i * 8192, R, C); const int Rb = Epi::PERM ? ((R & ~31) + perm32(R & 31)) : R;
        voffA[i] = (unsigned)(R * K + C) * 2u; voffB[i] = (unsigned)(Rb * K + C) * 2u; }
    const size_t kstep = (size_t)(BK * 2);
    const size_t hstep = (size_t)HALF * K * 2;
    const size_t tstep = 2 * hstep;
    const unsigned ldsw = (unsigned)wid * 1024u;
    const int aoff = lds_byte(wr * 64 + fr, fq * 8), boff = lds_byte(wc * 32 + fr, fq * 8);
#define PG8_SA(b, h) (((b) * 2 + (h)) * HTB)
#define PG8_SB(b, h) ((4 + (b) * 2 + (h)) * HTB)
#define PG8_STAGE(bufoff, gbase, voff) do { _Pragma("unroll") for (int _i = 0; _i < 2; ++_i) \
        __builtin_amdgcn_global_load_lds((const unsigned*)((const char*)(gbase) + (voff)[_i]), (PG8_LAS unsigned*)(lds + (bufoff) + ldsw + _i * 8192), 16, 0, 0); } while (0)
#define PG8_LDA(dst, b, h) do { _Pragma("unroll") for (int m = 0; m < 4; ++m) _Pragma("unroll") for (int k = 0; k < 2; ++k) dst[m][k] = *(const PG8_LAS bf16x8*)(lds + PG8_SA(b, h) + aoff + m * 2048 + k * 1024); } while (0)
#define PG8_LDB(dst, b, h) do { _Pragma("unroll") for (int n = 0; n < 2; ++n) _Pragma("unroll") for (int k = 0; k < 2; ++k) dst[n][k] = *(const PG8_LAS bf16x8*)(lds + PG8_SB(b, h) + boff + n * 2048 + k * 1024); } while (0)
#define PG8_MMA(ai, bj, At, Bt) do { __builtin_amdgcn_s_setprio(1); _Pragma("unroll") for (int m = 0; m < 4; ++m) _Pragma("unroll") for (int n = 0; n < 2; ++n) _Pragma("unroll") for (int k = 0; k < 2; ++k) \
        acc[ai][bj][m][n] = __builtin_amdgcn_mfma_f32_16x16x32_bf16(Bt[n][k], At[m][k], acc[ai][bj][m][n], 0, 0, 0); __builtin_amdgcn_s_setprio(0); } while (0)
#define PG8_WAIT_V(n) asm volatile("s_waitcnt vmcnt(" #n ")" ::: "memory")
#define PG8_WAIT_L(n) asm volatile("s_waitcnt lgkmcnt(" #n ")" ::: "memory")
#define PG8_BAR __builtin_amdgcn_s_barrier()
#define PG8_SCHED __builtin_amdgcn_sched_barrier(0)
    Unit cur, nxt; int ui = 0;
    if (!S.next(0, cur)) return;
    f32x4 acc[2][2][4][2];
#pragma unroll
    for (int a = 0; a < 2; ++a)
#pragma unroll
        for (int b = 0; b < 2; ++b)
#pragma unroll
            for (int m = 0; m < 4; ++m)
#pragma unroll
                for (int n = 0; n < 2; ++n) acc[a][b][m][n] = (f32x4){0.f, 0.f, 0.f, 0.f};
    bf16x8 At[4][2], B0[2][2], B1[2][2];
    const char* cA = (const char*)g.A + (size_t)cur.pm * tstep; const char* cB = (const char*)g.Bt + (size_t)cur.pn * tstep;
    S.a_ready(cur);
    if constexpr (SP2) {
        PG8_STAGE(PG8_SB(0, 0), cB, voffB); PG8_STAGE(PG8_SB(0, 1), cB + hstep, voffB); PG8_STAGE(PG8_SA(0, 0), cA, voffA); PG8_STAGE(PG8_SA(0, 1), cA + hstep, voffA);
        if (wr == 1) PG8_BAR;
        PG8_WAIT_V(2); PG8_BAR;
        PG8_STAGE(PG8_SB(1, 0), cB + kstep, voffB); PG8_STAGE(PG8_SA(1, 0), cA + kstep, voffA); PG8_STAGE(PG8_SB(1, 1), cB + hstep + kstep, voffB);
        PG8_WAIT_V(6); PG8_BAR;
    } else {
        PG8_STAGE(PG8_SB(0, 0), cB, voffB); PG8_STAGE(PG8_SA(0, 0), cA, voffA); PG8_STAGE(PG8_SB(0, 1), cB + hstep, voffB); PG8_STAGE(PG8_SA(0, 1), cA + hstep, voffA);
        if (wr == 1) PG8_BAR;
        PG8_WAIT_V(4); PG8_BAR;
        PG8_STAGE(PG8_SB(1, 0), cB + kstep, voffB); PG8_STAGE(PG8_SA(1, 0), cA + kstep, voffA); PG8_STAGE(PG8_SB(1, 1), cB + hstep + kstep, voffB);
        PG8_WAIT_V(6); PG8_BAR;
    }
    for (;;) {
        const bool has_next = S.next(ui + 1, nxt);
        const char* nA = has_next ? (const char*)g.A + (size_t)nxt.pm * tstep : cA; const char* nB = has_next ? (const char*)g.Bt + (size_t)nxt.pn * tstep : cB;
        for (int t = 0; t < nt; t += 2) {
            const bool last = (t == nt - 2);
            const char* a1 = cA + (size_t)(t + 1) * kstep;
            const char* a2 = last ? nA : cA + (size_t)(t + 2) * kstep; const char* b2 = last ? nB : cB + (size_t)(t + 2) * kstep;
            const char* a3 = a2 + kstep; const char* b3 = b2 + kstep;
            if (last && has_next) S.a_ready(nxt);
            if constexpr (SP2) {
            PG8_LDB(B0, 0, 0); PG8_LDB(B1, 0, 1); PG8_SCHED; PG8_LDA(At, 0, 0); PG8_STAGE(PG8_SA(1, 1), a1 + hstep, voffA);
            PG8_WAIT_V(8); PG8_WAIT_L(0); PG8_BAR; PG8_MMA(0, 0, At, B0); PG8_MMA(0, 1, At, B1); PG8_BAR; PG8_SCHED;
            PG8_LDA(At, 0, 1); PG8_STAGE(PG8_SB(0, 0), b2, voffB); PG8_STAGE(PG8_SB(0, 1), b2 + hstep, voffB); PG8_STAGE(PG8_SA(0, 0), a2, voffA);
            PG8_WAIT_V(8); PG8_WAIT_L(0); PG8_BAR; PG8_MMA(1, 0, At, B0); PG8_MMA(1, 1, At, B1); PG8_BAR; PG8_SCHED;
            PG8_LDB(B0, 1, 0); PG8_LDB(B1, 1, 1); PG8_SCHED; PG8_LDA(At, 1, 0); PG8_STAGE(PG8_SA(0, 1), a2 + hstep, voffA);
            PG8_WAIT_V(8); PG8_WAIT_L(0); PG8_BAR; PG8_MMA(0, 0, At, B0); PG8_MMA(0, 1, At, B1); PG8_BAR; PG8_SCHED;
            PG8_LDA(At, 1, 1); PG8_STAGE(PG8_SB(1, 0), b3, voffB); PG8_STAGE(PG8_SB(1, 1), b3 + hstep, voffB); PG8_STAGE(PG8_SA(1, 0), a3, voffA);
            PG8_WAIT_V(8); PG8_WAIT_L(0); PG8_BAR; PG8_MMA(1, 0, At, B0); PG8_MMA(1, 1, At, B1); PG8_BAR; PG8_SCHED;
            } else {
            PG8_LDB(B0, 0, 0); PG8_SCHED; PG8_LDA(At, 0, 0); PG8_STAGE(PG8_SA(1, 1), a1 + hstep, voffA);
            PG8_WAIT_L(8); PG8_BAR; PG8_WAIT_L(0); PG8_MMA(0, 0, At, B0); PG8_BAR; PG8_SCHED;
            PG8_LDB(B1, 0, 1); PG8_STAGE(PG8_SB(0, 0), b2, voffB);
            PG8_BAR; PG8_WAIT_L(0); PG8_MMA(0, 1, At, B1); PG8_BAR;
            PG8_LDA(At, 0, 1); PG8_STAGE(PG8_SA(0, 0), a2, voffA);
            PG8_BAR; PG8_WAIT_L(0); PG8_MMA(1, 0, At, B0); PG8_BAR; PG8_SCHED;
            PG8_STAGE(PG8_SB(0, 1), b2 + hstep, voffB);
            PG8_WAIT_V(6); PG8_BAR; PG8_MMA(1, 1, At, B1); PG8_BAR;
            PG8_LDB(B0, 1, 0); PG8_SCHED; PG8_LDA(At, 1, 0); PG8_STAGE(PG8_SA(0, 1), a2 + hstep, voffA);
            PG8_WAIT_L(8); PG8_BAR; PG8_WAIT_L(0); PG8_MMA(0, 0, At, B0); PG8_BAR; PG8_SCHED;
            PG8_LDB(B1, 1, 1); PG8_STAGE(PG8_SB(1, 0), b3, voffB);
            PG8_BAR; PG8_WAIT_L(0); PG8_MMA(0, 1, At, B1); PG8_BAR;
            PG8_LDA(At, 1, 1); PG8_STAGE(PG8_SA(1, 0), a3, voffA);
            PG8_BAR; PG8_WAIT_L(0); PG8_MMA(1, 0, At, B0); PG8_BAR; PG8_SCHED;
            PG8_STAGE(PG8_SB(1, 1), b3 + hstep, voffB);
            PG8_WAIT_V(6); PG8_BAR; PG8_MMA(1, 1, At, B1); PG8_BAR;
            }
        }
        if constexpr (ALIGN_EPI) { if (wr == 0) PG8_BAR; }
        if constexpr (!Epi::AFTER_DRAIN) { E(acc, cur, wr, wc, fr, fq); S.done(cur); }
        if (!has_next) break;
#pragma unroll
        for (int a = 0; a < 2; ++a)
#pragma unroll
            for (int b = 0; b < 2; ++b)
#pragma unroll
                for (int m = 0; m < 4; ++m)
#pragma unroll
                    for (int n = 0; n < 2; ++n) acc[a][b][m][n] = (f32x4){0.f, 0.f, 0.f, 0.f};
        cur = nxt; cA = nA; cB = nB; ++ui;
        if constexpr (ALIGN_EPI) { if (wr == 1) PG8_BAR; }
    }
    PG8_WAIT_V(0);
    if constexpr (!ALIGN_EPI) { if (wr == 0) PG8_BAR; }
    PG8_BAR;
    if constexpr (Epi::AFTER_DRAIN) { E.fused(acc, cur, wr, wc, fr, fq, lds, wid, lane); S.done(cur); }
#undef PG8_SA
#undef PG8_SB
#undef PG8_STAGE
#undef PG8_LDA
#undef PG8_LDB
#undef PG8_MMA
#undef PG8_WAIT_V
#undef PG8_WAIT_L
#undef PG8_BAR
#undef PG8_SCHED
}
}

#ifndef PG8_SP2
#define PG8_SP2 true
#endif
#ifndef PG8_ALIGN
#define PG8_ALIGN true
#endif
#define GAS __attribute__((address_space(1)))
#define LAS __attribute__((address_space(3)))
typedef unsigned short bf16;
typedef unsigned v4u __attribute__((ext_vector_type(4)));
typedef float f32x4 __attribute__((ext_vector_type(4)));
typedef short bf16x8 __attribute__((ext_vector_type(8)));
typedef GAS unsigned gu32;
typedef GAS unsigned long long gu64;
#define RLX_AGENT __ATOMIC_RELAXED, __HIP_MEMORY_SCOPE_AGENT
#define LDS_WAIT() asm volatile("s_waitcnt lgkmcnt(0)" ::: "memory")
#define VM_WAIT() asm volatile("s_waitcnt vmcnt(0)" ::: "memory")
__device__ __forceinline__ unsigned long long rt() { return __builtin_amdgcn_s_memrealtime(); }
__device__ __forceinline__ unsigned f2bf(float f) { unsigned u = __builtin_bit_cast(unsigned, f); return (u + 0x7fffu + ((u >> 16) & 1u)) >> 16; }
__device__ __forceinline__ unsigned pk2(float lo, float hi) { return f2bf(lo) | (f2bf(hi) << 16); }

#define XB_TMO      128
#define XB_XCNT(j)  (256  + 64 * (j))
#define XB_XSUB(j)  (1280 + 64 * (j))
#define XB_XGEN(j)  (2304 + 64 * (j))
#define XB_TOP      3328
#define XB_TOPGEN   3392
#define XCD_BAR_WORDS 3456
#define XB_SPIN_CAP (1u << 18)

__device__ __forceinline__ unsigned xb_ld(unsigned* p)              { return __hip_atomic_load(p, __ATOMIC_RELAXED, __HIP_MEMORY_SCOPE_AGENT); }
__device__ __forceinline__ unsigned xb_add(unsigned* p, unsigned v) { return __hip_atomic_fetch_add(p, v, __ATOMIC_RELAXED, __HIP_MEMORY_SCOPE_AGENT); }
__device__ __forceinline__ unsigned xb_xcc_id() { return (unsigned)__builtin_amdgcn_s_getreg((3 << 11) | 20) & 0xFu; }
#define XB_SPIN(cond, bar) do { unsigned _sp = 0; while (cond) { __builtin_amdgcn_s_sleep(1); \
    if ((++_sp & 255u) == 0u) { if (xb_ld(&(bar)[XB_TMO])) break; if (_sp > XB_SPIN_CAP) { atomicAdd(&(bar)[XB_TMO], 1u); break; } } } } while (0)

struct XcdBarrier {
    unsigned* bar; unsigned x;
    volatile LAS unsigned* st;
};

__device__ __forceinline__ XcdBarrier xcd_barrier_post(unsigned* bar, volatile LAS unsigned* st) {
    XcdBarrier b; b.bar = bar; b.x = xb_xcc_id(); b.st = st;
    if (threadIdx.x == 0) (void)xb_add(&bar[XB_XCNT(b.x)], 1u);
    return b;
}
__device__ __forceinline__ void xcd_barrier_complete(unsigned* bar, unsigned x, unsigned& nloc, unsigned& nx) {
    const unsigned G = gridDim.x * gridDim.y * gridDim.z;
    unsigned sum, cnt, mine, sp = 0u;
    for (;;) {
        sum = 0u; cnt = 0u; mine = 0u;
#pragma unroll
        for (unsigned j = 0; j < 16; ++j) { const unsigned c = xb_ld(&bar[XB_XCNT(j)]); sum += c; cnt += (c > 0u) ? 1u : 0u; mine = (j == x) ? c : mine; }
        if (sum == G) break;
        __builtin_amdgcn_s_sleep(1);
        if ((++sp & 255u) == 0u) { if (xb_ld(&bar[XB_TMO])) break; if (sp > XB_SPIN_CAP) { atomicAdd(&bar[XB_TMO], 1u); break; } }
    }
    nloc = mine > 0u ? mine : 1u; nx = cnt > 0u ? cnt : 1u;
}

__device__ __forceinline__ void xcd_barrier(const XcdBarrier& b) {
    asm volatile("s_waitcnt vmcnt(0)" ::: "memory");
    __syncthreads();
    if (threadIdx.x == 0) {
        unsigned* bar = b.bar;
        __builtin_amdgcn_s_waitcnt(0);
        unsigned nloc = b.st[0], nx = b.st[1];
        if (nloc == 0u) { xcd_barrier_complete(bar, b.x, nloc, nx); b.st[0] = nloc; b.st[1] = nx; }
        const unsigned old = xb_add(&bar[XB_XSUB(b.x)], 1u);
        const unsigned gen = old / nloc;
        if (old + 1u == (gen + 1u) * nloc) {
            __builtin_amdgcn_fence(__ATOMIC_RELEASE, "agent");
            asm volatile("s_waitcnt vmcnt(0)" ::: "memory");
            const unsigned og = xb_add(&bar[XB_TOP], 1u);
            const unsigned tg = og / nx;
            if (og + 1u == (tg + 1u) * nx) xb_add(&bar[XB_TOPGEN], 1u);
            else XB_SPIN(xb_ld(&bar[XB_TOPGEN]) == tg, bar);
            __builtin_amdgcn_fence(__ATOMIC_ACQUIRE, "agent");
            xb_add(&bar[XB_XGEN(b.x)], 1u);
            asm volatile("s_waitcnt vmcnt(0)" ::: "memory");
        } else {
            XB_SPIN(xb_ld(&bar[XB_XGEN(b.x)]) == gen, bar);
            __builtin_amdgcn_fence(__ATOMIC_ACQUIRE, "agent");
            asm volatile("s_waitcnt vmcnt(0)" ::: "memory");
        }
    }
    __syncthreads();
}
using pg8::silu_f; using pg8::sigmoid_f;
constexpr int NWAVES = 8;
#ifndef MK_N_LAUNCHES
#define MK_N_LAUNCHES 12
#endif
constexpr int PER_PHASE = 12;
constexpr int N_LAUNCHES = MK_N_LAUNCHES;

constexpr int T = 8192, D = 1024, FF = 2816, M = 2 * T, DIN = 3328, NMOD = 9 * D;
constexpr float EPS = 1e-6f;
constexpr int ZC_Q = 0, ZC_GF = 512, ZC_GB = 1024, ZC_V = 1536, ZC_GATE = 2048, ZC_AQ = 2560, ZC_AK = 3072, ZC_AV = 3200;

constexpr size_t MiB = 1u << 20;
constexpr size_t WS_CTL = 0, CTL_ZERO_BYTES = 1 * MiB;
constexpr size_t WS_PART = 1 * MiB;
constexpr size_t WS_MODS = WS_PART + 640 * 1024;
constexpr size_t WS_LB = WS_MODS + 80 * 1024;
constexpr size_t WS_TB = WS_LB + 4096;
constexpr size_t WS_W1I = 2 * MiB, WS_W1O = 13 * MiB, WS_W2I = 19 * MiB, WS_W2O = 30 * MiB, WS_WMI = 36 * MiB, WS_WMO = 43 * MiB;
constexpr size_t WS_H = 46 * MiB;
constexpr size_t WS_MIX = 78 * MiB;
constexpr size_t WS_ZH = 110 * MiB;
constexpr size_t WS_SLOC = 214 * MiB;
constexpr size_t WS_SIN = 230 * MiB;
constexpr size_t WS_DSEG = 238 * MiB;
constexpr size_t WS_END = 256 * MiB;
static_assert(WS_TB + 8 * 512 * 4 <= WS_W1I && WS_W1I + (size_t)2 * FF * D * 2 <= WS_W1O && WS_W1O + (size_t)D * FF * 2 <= WS_W2I && WS_W2I + (size_t)2 * FF * D * 2 <= WS_W2O &&
              WS_W2O + (size_t)D * FF * 2 <= WS_WMI && WS_WMI + (size_t)DIN * D * 2 <= WS_WMO && WS_WMO + (size_t)D * D * 2 <= WS_H && WS_H + (size_t)M * D * 2 <= WS_MIX &&
              WS_MIX + (size_t)M * D * 2 <= WS_ZH && WS_ZH + (size_t)M * DIN * 2 <= WS_SLOC, "d_ws map");
constexpr int CW_TMO = 0, CW_CODE = 1, CW_BAR = 4096;

constexpr int RING_OFF = 0, RING_BYTES = 131072;
constexpr int LDSCTL_OFF = RING_BYTES, MISC_OFF = LDSCTL_OFF + 320;
constexpr int LDS_BYTES = 147456;
static_assert(MISC_OFF + 128 <= LDS_BYTES, "LDS map");

struct Frame {
    LAS unsigned char* lds;
    volatile LAS unsigned* MISC;
    gu32* ctl;
    int tid, lane, wave;
    int vcu, G;
};

__device__ __forceinline__ float wave_sum(float v) {
#pragma unroll
    for (int o = 1; o < 64; o <<= 1) v += __shfl_xor(v, o);
    return v;
}
__device__ __forceinline__ float bf2f(bf16 v) { return __builtin_bit_cast(float, (unsigned)v << 16); }
__device__ __forceinline__ float bflo(unsigned w) { return __builtin_bit_cast(float, w << 16); }
__device__ __forceinline__ float bfhi(unsigned w) { return __builtin_bit_cast(float, w & 0xffff0000u); }

__device__ __forceinline__ void p0_transpose_item(const float* W, int K, int N, bf16* WT, int k0, int n0, int dst_row0, LAS float* scr, int lane) {
#pragma unroll 8
    for (int i = 0; i < 32; ++i) { const int kk = 2 * i + (lane >> 5); scr[kk * 33 + (lane & 31)] = W[(size_t)(k0 + kk) * N + n0 + (lane & 31)]; }
    LDS_WAIT(); asm volatile("" ::: "memory");
    const int c = lane & 7;
#pragma unroll
    for (int j = 0; j < 4; ++j) { const int n = (lane >> 3) + 8 * j; const LAS float* s = scr + (8 * c) * 33 + n;
        v4u o; o.x = pk2(s[0 * 33], s[1 * 33]); o.y = pk2(s[2 * 33], s[3 * 33]); o.z = pk2(s[4 * 33], s[5 * 33]); o.w = pk2(s[6 * 33], s[7 * 33]);
        *(GAS v4u*)(WT + (size_t)(dst_row0 + n) * K + k0 + 8 * c) = o; }
    LDS_WAIT(); asm volatile("" ::: "memory");
}
__device__ __forceinline__ void p0_transpose_nat(const float* W, int K, int N, bf16* WT, LAS float* scr, int item, int lane) {
    const int nblk = N / 32, kb = item / nblk, nb = item % nblk;
    p0_transpose_item(W, K, N, WT, 64 * kb, 32 * nb, 32 * nb, scr, lane);
}
__device__ __forceinline__ void p0_transpose_glu(const float* W, bf16* WT, LAS float* scr, int item, int lane) {
    const int nblk = (2 * FF) / 32, kb = item / nblk, nb = item % nblk, n0 = 32 * nb;
    const int up = n0 >= FF, nn = n0 - (up ? FF : 0), dst = 256 * (nn >> 7) + (up ? 128 : 0) + (nn & 127);
    p0_transpose_item(W, D, 2 * FF, WT, 64 * kb, n0, dst, scr, lane);
}
__device__ __forceinline__ int t5_bucket(int rel) {
    const int n = rel < 0 ? -rel : rel; int r = rel > 0 ? 16 : 0;
    if (n < 8) return r + n;
    return r + 8 + (n >= 12) + (n >= 16) + (n >= 23) + (n >= 32) + (n >= 46) + (n >= 64) + (n >= 91);
}

struct Ptrs {
    const float *x, *c, *w_ada, *b_ada, *norm_g, *w1i, *w1o, *w2i, *w2o, *wmi, *wmo, *hlb, *hng, *qkg, *sink, *relb;
    float* out; unsigned char* ws;
};

__device__ __forceinline__ void phase_p0a(Frame& F, const Ptrs& P) {
    float* part = (float*)(P.ws + WS_PART);
    for (int it = blockIdx.x; it < 36 * 8; it += F.G) {
        const int cg = it % 36, ks = it / 36, k0 = ks * 128 + F.wave * 16;
        f32x4 a0 = {0.f, 0.f, 0.f, 0.f}, a1 = {0.f, 0.f, 0.f, 0.f};
        const float* wp = P.w_ada + (size_t)k0 * NMOD + cg * 256 + 4 * F.lane;
#pragma unroll 4
        for (int r = 0; r < 16; ++r) { const f32x4 w = *(const f32x4*)(wp + (size_t)r * NMOD);
            const float c0 = P.c[k0 + r], c1 = P.c[D + k0 + r];
            a0 += w * silu_f(c0); a1 += w * silu_f(c1); }
        LAS f32x4* red = (LAS f32x4*)F.lds;
        red[(F.wave * 2 + 0) * 64 + F.lane] = a0; red[(F.wave * 2 + 1) * 64 + F.lane] = a1;
        __syncthreads();
        if (F.tid < 128) { const int b = F.tid >> 6, l = F.tid & 63; f32x4 s = {0.f, 0.f, 0.f, 0.f};
#pragma unroll
            for (int w = 0; w < 8; ++w) s += red[(w * 2 + b) * 64 + l];
            *(f32x4*)(part + ((size_t)(ks * 2 + b)) * NMOD + cg * 256 + 4 * l) = s; }
        __syncthreads();
    }
    if (blockIdx.x == 0) {
        float* lbp = (float*)(P.ws + WS_LB);
        for (int i = F.tid; i < 1024; i += 512) { const int d = i >> 9, c = i & 511; lbp[i] = 1.0f / (1.0f + expf(P.hlb[d * 1024 + 512 + c] - P.hlb[d * 1024 + c])); }
    }
    LAS float* scr = (LAS float*)(F.lds + 16384 + F.wave * 12288);
    const int gw = F.vcu * NWAVES + F.wave, NGW = F.G * NWAVES;
    constexpr int I_1I = (D / 64) * (2 * FF / 32), I_1O = (FF / 64) * (D / 32), I_MI = (D / 64) * (DIN / 32), I_MO = (D / 64) * (D / 32);
    constexpr int NITEMS = 2 * (I_1I + I_1O) + I_MI + I_MO;
    for (int it = gw; it < NITEMS; it += NGW) {
        int r = it;
        if (r < I_1I) { p0_transpose_glu(P.w1i, (bf16*)(P.ws + WS_W1I), scr, r, F.lane); continue; } r -= I_1I;
        if (r < I_1O) { p0_transpose_nat(P.w1o, FF, D, (bf16*)(P.ws + WS_W1O), scr, r, F.lane); continue; } r -= I_1O;
        if (r < I_MI) { p0_transpose_nat(P.wmi, D, DIN, (bf16*)(P.ws + WS_WMI), scr, r, F.lane); continue; } r -= I_MI;
        if (r < I_MO) { p0_transpose_nat(P.wmo, D, D, (bf16*)(P.ws + WS_WMO), scr, r, F.lane); continue; } r -= I_MO;
        if (r < I_1I) { p0_transpose_glu(P.w2i, (bf16*)(P.ws + WS_W2I), scr, r, F.lane); continue; } r -= I_1I;
        p0_transpose_nat(P.w2o, FF, D, (bf16*)(P.ws + WS_W2O), scr, r, F.lane);
    }
}

__device__ __forceinline__ void phase_norm(Frame& F, const Ptrs& P, const float* src, const float* g, int mod0, bool first) {
    const float* part = (const float*)(P.ws + WS_PART); float* mods = (float*)(P.ws + WS_MODS);
    LAS float* AB = (LAS float*)F.lds;
    if (first) {
        for (int idx = blockIdx.x * 512 + F.tid; idx < 2 * NMOD; idx += F.G * 512) { const int b = idx / NMOD, j = idx % NMOD; float s = P.b_ada[j];
#pragma unroll
            for (int ks = 0; ks < 8; ++ks) s += part[(size_t)(ks * 2 + b) * NMOD + j];
            mods[idx] = s; }
    }
    for (int i = F.tid; i < 2048; i += 512) { const int b = i >> 10, col = i & 1023; float sh, sc;
        if (first) { sh = P.b_ada[mod0 * D + col]; sc = P.b_ada[(mod0 + 1) * D + col];
#pragma unroll
            for (int ks = 0; ks < 8; ++ks) { sh += part[(size_t)(ks * 2 + b) * NMOD + mod0 * D + col]; sc += part[(size_t)(ks * 2 + b) * NMOD + (mod0 + 1) * D + col]; } }
        else { sh = mods[b * NMOD + mod0 * D + col]; sc = mods[b * NMOD + (mod0 + 1) * D + col]; }
        AB[(b * 2 + 0) * 1024 + col] = g[col] * (1.0f + sc); AB[(b * 2 + 1) * 1024 + col] = sh; }
    __syncthreads();
    bf16* dst = (bf16*)(P.ws + WS_H);
    const int gw = F.vcu * NWAVES + F.wave, NGW = F.G * NWAVES;
    for (int m = gw; m < M; m += NGW) {
        const int b = m >= T;
        const GAS f32x4* xr = (const GAS f32x4*)(src + (size_t)m * D) + F.lane;
        f32x4 v[4]; float s = 0.f;
#pragma unroll
        for (int j = 0; j < 4; ++j) { v[j] = xr[64 * j]; s += (v[j].x * v[j].x + v[j].y * v[j].y) + (v[j].z * v[j].z + v[j].w * v[j].w); }
        const float r = 1.0f / sqrtf(wave_sum(s) * (1.f / D) + EPS);
        GAS unsigned long long* o8 = (GAS unsigned long long*)(dst + (size_t)m * D) + F.lane;
#pragma unroll
        for (int j = 0; j < 4; ++j) { const f32x4 a = *(const LAS f32x4*)(AB + (b * 2 + 0) * 1024 + 256 * j + 4 * F.lane), sh = *(const LAS f32x4*)(AB + (b * 2 + 1) * 1024 + 256 * j + 4 * F.lane);
            const f32x4 o = v[j] * r * a + sh;
            o8[64 * j] = (unsigned long long)pk2(o.x, o.y) | ((unsigned long long)pk2(o.z, o.w) << 32); }
    }
    __syncthreads();
}

__device__ __forceinline__ void hgrn_naive_scan(Frame& F, const Ptrs& P) {
    const bf16* Z = (const bf16*)(P.ws + WS_ZH); bf16* OL = (bf16*)(P.ws + WS_H);
    const int gw = F.vcu * NWAVES + F.wave, NGW = F.G * NWAVES;
    for (int item = gw; item < 2048; item += NGW) {
        const int e = item & 127, dir = (item >> 7) & 1, h = (item >> 8) & 3, b = item >> 10;
        const bf16* Zb = Z + (size_t)b * T * DIN;
        float s0 = 0.f, s1 = 0.f;
        const int qc = ZC_Q + h * 128 + F.lane, gc = (dir ? ZC_GB : ZC_GF) + h * 128 + F.lane, vc = ZC_V + h * 128 + e;
#pragma unroll 4
        for (int tt = 0; tt < T; ++tt) {
            const int t = dir ? (T - 1 - tt) : tt; const bf16* row = Zb + (size_t)t * DIN;
            const float q0 = bf2f(row[qc]), q1 = bf2f(row[qc + 64]), g0 = bf2f(row[gc]), g1 = bf2f(row[gc + 64]), v = bf2f(row[vc]);
            const float f0 = __expf(g0), f1 = __expf(g1);
            s0 = f0 * s0 + (1.0f - f0) * v; s1 = f1 * s1 + (1.0f - f1) * v;
            const float o = wave_sum(q0 * s0 + q1 * s1);
            if (F.lane == 0) OL[((size_t)dir * M + (size_t)b * T + t) * 512 + h * 128 + e] = (bf16)f2bf(o);
        }
    }
}
__device__ __forceinline__ void attn_naive(Frame& F, const Ptrs& P) {
    const bf16* Z = (const bf16*)(P.ws + WS_ZH); bf16* MIX = (bf16*)(P.ws + WS_MIX);
    for (int item = blockIdx.x * 512 + F.tid; item < 8 * M; item += F.G * 512) {
        const int hq = item / M, m = item % M, b = m / T, t = m % T, kv = hq >> 2;
        float q[64], o[64];
        { const v4u* qp = (const v4u*)(Z + (size_t)m * DIN + ZC_AQ + hq * 64); float ss = 0.f;
#pragma unroll
          for (int i = 0; i < 8; ++i) { const v4u w = qp[i];
              q[8 * i + 0] = bflo(w.x); q[8 * i + 1] = bfhi(w.x); q[8 * i + 2] = bflo(w.y); q[8 * i + 3] = bfhi(w.y); q[8 * i + 4] = bflo(w.z); q[8 * i + 5] = bfhi(w.z); q[8 * i + 6] = bflo(w.w); q[8 * i + 7] = bfhi(w.w); }
#pragma unroll
          for (int d = 0; d < 64; ++d) ss += q[d] * q[d];
          const float r = 0.125f / sqrtf(ss * (1.f / 64.f) + EPS);
#pragma unroll
          for (int d = 0; d < 64; ++d) { q[d] = q[d] * r * P.qkg[d] * P.qkg[64 + d]; o[d] = 0.f; } }
        float mrun = P.sink[hq], l = 1.0f;
        const int j0 = t - 128 < 0 ? 0 : t - 128, j1 = t + 128 > T - 1 ? T - 1 : t + 128;
        for (int j = j0; j <= j1; ++j) {
            const v4u* kp = (const v4u*)(Z + ((size_t)b * T + j) * DIN + ZC_AK + kv * 64); float ss = 0.f, dot = 0.f;
#pragma unroll
            for (int i = 0; i < 8; ++i) { const v4u w = kp[i]; float k[8] = {bflo(w.x), bfhi(w.x), bflo(w.y), bfhi(w.y), bflo(w.z), bfhi(w.z), bflo(w.w), bfhi(w.w)};
#pragma unroll
                for (int jj = 0; jj < 8; ++jj) { ss += k[jj] * k[jj]; dot += k[jj] * q[8 * i + jj]; } }
            const float logit = dot / sqrtf(ss * (1.f / 64.f) + EPS) + P.relb[t5_bucket(j - t) * 8 + hq];
            if (logit > mrun) { const float sc = __expf(mrun - logit); l *= sc;
#pragma unroll
                for (int d = 0; d < 64; ++d) o[d] *= sc;
                mrun = logit; }
            const float p = __expf(logit - mrun); l += p;
            const v4u* vp = (const v4u*)(Z + ((size_t)b * T + j) * DIN + ZC_AV + kv * 64);
#pragma unroll
            for (int i = 0; i < 8; ++i) { const v4u w = vp[i];
                o[8 * i + 0] += p * bflo(w.x); o[8 * i + 1] += p * bfhi(w.x); o[8 * i + 2] += p * bflo(w.y); o[8 * i + 3] += p * bfhi(w.y);
                o[8 * i + 4] += p * bflo(w.z); o[8 * i + 5] += p * bfhi(w.z); o[8 * i + 6] += p * bflo(w.w); o[8 * i + 7] += p * bfhi(w.w); }
        }
        const float il = 1.0f / l;
        v4u* op = (v4u*)(MIX + (size_t)m * D + 512 + hq * 64);
#pragma unroll
        for (int i = 0; i < 8; ++i) { v4u w; w.x = pk2(o[8 * i] * il, o[8 * i + 1] * il); w.y = pk2(o[8 * i + 2] * il, o[8 * i + 3] * il); w.z = pk2(o[8 * i + 4] * il, o[8 * i + 5] * il); w.w = pk2(o[8 * i + 6] * il, o[8 * i + 7] * il); op[i] = w; }
    }
}
__device__ __forceinline__ void hgrn_naive_combine(Frame& F, const Ptrs& P) {
    const bf16* Z = (const bf16*)(P.ws + WS_ZH); const bf16* OL = (const bf16*)(P.ws + WS_H); bf16* MIX = (bf16*)(P.ws + WS_MIX);
    const int gw = F.vcu * NWAVES + F.wave, NGW = F.G * NWAVES;
    for (int item = gw; item < 4 * M; item += NGW) {
        const int m = item >> 2, h = item & 3, c0 = h * 128 + F.lane;
        const float a0 = bf2f(OL[(size_t)m * 512 + c0]) + bf2f(OL[((size_t)M + m) * 512 + c0]), a1 = bf2f(OL[(size_t)m * 512 + c0 + 64]) + bf2f(OL[((size_t)M + m) * 512 + c0 + 64]);
        const float r = 1.0f / sqrtf(wave_sum(a0 * a0 + a1 * a1) * (1.f / 128.f) + EPS);
        MIX[(size_t)m * D + c0] = (bf16)f2bf(a0 * r * P.hng[c0] * bf2f(Z[(size_t)m * DIN + ZC_GATE + c0]));
        MIX[(size_t)m * D + c0 + 64] = (bf16)f2bf(a1 * r * P.hng[c0 + 64] * bf2f(Z[(size_t)m * DIN + ZC_GATE + c0 + 64]));
    }
}

struct Args { Ptrs p; int ph_lo, ph_hi, li, pad; };
__global__ void __launch_bounds__(NWAVES * 64, 2) mk_fwd(Args args) {
    extern __shared__ __attribute__((aligned(16))) unsigned char lds[];
    Frame F;
    F.lds = (LAS unsigned char*)lds;
    F.MISC = (volatile LAS unsigned*)(F.lds + MISC_OFF);
    F.tid = threadIdx.x; F.lane = F.tid & 63; F.wave = __builtin_amdgcn_readfirstlane(F.tid >> 6);
    F.G = gridDim.x; { const int bx = blockIdx.x; F.vcu = (F.G % 8 == 0) ? (bx % 8) * (F.G / 8) + bx / 8 : bx; }
    const Ptrs& P = args.p;
    F.ctl = (gu32*)(P.ws + WS_CTL);
    for (int u = F.tid; u < (LDS_BYTES - LDSCTL_OFF) / 4; u += NWAVES * 64) ((LAS unsigned*)(F.lds + LDSCTL_OFF))[u] = 0u;
    __syncthreads();
    XcdBarrier bar; bar.bar = (unsigned*)(F.ctl + CW_BAR); bar.x = 0; bar.st = nullptr;
    if (N_LAUNCHES != PER_PHASE) bar = xcd_barrier_post((unsigned*)(F.ctl + CW_BAR), F.MISC + 8);
#define GRID_BAR() do { if (N_LAUNCHES != PER_PHASE) xcd_barrier(bar); } while (0)
    const int lo = args.ph_lo, hi = args.ph_hi;
#define IN(k) (lo <= (k) && (k) < hi)
#define BOTH(k) (IN(k) && IN((k) + 1))
    bf16* const Hb = (bf16*)(P.ws + WS_H); bf16* const ZH = (bf16*)(P.ws + WS_ZH); bf16* const MIXb = (bf16*)(P.ws + WS_MIX);
    const float* const mods = (const float*)(P.ws + WS_MODS);

    if (IN(0)) { phase_p0a(F, P); if (BOTH(0)) GRID_BAR(); }
    if (IN(1)) { phase_norm(F, P, P.x, P.norm_g, 0, true); if (BOTH(1)) GRID_BAR(); }
    if (IN(2)) {
        pg8::Gemm g{Hb, (const bf16*)(P.ws + WS_W1I), M, 2 * FF, D}; pg8::StaticOrder S; S.init(M, 2 * FF, F.G, (int)blockIdx.x);
        pg8::EpiSwiGLU E{ZH, FF};
        pg8::gemm_phase<pg8::EpiSwiGLU, pg8::StaticOrder, PG8_ALIGN, PG8_SP2>(F.lds + RING_OFF, g, S, E);
        if (BOTH(2)) GRID_BAR();
    }
    if (IN(3)) {
        pg8::Gemm g{ZH, (const bf16*)(P.ws + WS_W1O), M, D, FF}; pg8::StaticOrder S; S.init(M, D, F.G, (int)blockIdx.x);
        pg8::EpiResid E{P.x, P.out, mods + 2 * D, NMOD, 0.5f};
        pg8::gemm_phase<pg8::EpiResid, pg8::StaticOrder, PG8_ALIGN, PG8_SP2>(F.lds + RING_OFF, g, S, E);
        if (BOTH(3)) GRID_BAR();
    }
    if (IN(4)) { phase_norm(F, P, P.out, P.norm_g + D, 3, false); if (BOTH(4)) GRID_BAR(); }
    if (IN(5)) {
        pg8::Gemm g{Hb, (const bf16*)(P.ws + WS_WMI), M, DIN, D}; pg8::StaticOrder S; S.init(M, DIN, F.G, (int)blockIdx.x);
        pg8::EpiMixIn E{ZH, (const float*)(P.ws + WS_LB)};
        pg8::gemm_phase<pg8::EpiMixIn, pg8::StaticOrder, PG8_ALIGN, PG8_SP2>(F.lds + RING_OFF, g, S, E);
        if (BOTH(5)) GRID_BAR();
    }
    if (IN(6)) { hgrn_naive_scan(F, P); attn_naive(F, P); if (BOTH(6)) GRID_BAR(); }
    if (IN(7)) { hgrn_naive_combine(F, P); if (BOTH(7)) GRID_BAR(); }
    if (IN(8)) {
        pg8::Gemm g{MIXb, (const bf16*)(P.ws + WS_WMO), M, D, D}; pg8::StaticOrder S; S.init(M, D, F.G, (int)blockIdx.x);
        pg8::EpiResid E{P.out, P.out, mods + 5 * D, NMOD, 1.0f};
        pg8::gemm_phase<pg8::EpiResid, pg8::StaticOrder, PG8_ALIGN, PG8_SP2>(F.lds + RING_OFF, g, S, E);
        if (BOTH(8)) GRID_BAR();
    }
    if (IN(9)) { phase_norm(F, P, P.out, P.norm_g + 2 * D, 6, false); if (BOTH(9)) GRID_BAR(); }
    if (IN(10)) {
        pg8::Gemm g{Hb, (const bf16*)(P.ws + WS_W2I), M, 2 * FF, D}; pg8::StaticOrder S; S.init(M, 2 * FF, F.G, (int)blockIdx.x);
        pg8::EpiSwiGLU E{ZH, FF};
        pg8::gemm_phase<pg8::EpiSwiGLU, pg8::StaticOrder, PG8_ALIGN, PG8_SP2>(F.lds + RING_OFF, g, S, E);
        if (BOTH(10)) GRID_BAR();
    }
    if (IN(11)) {
        pg8::Gemm g{ZH, (const bf16*)(P.ws + WS_W2O), M, D, FF}; pg8::StaticOrder S; S.init(M, D, F.G, (int)blockIdx.x);
        pg8::EpiResid E{P.out, P.out, mods + 8 * D, NMOD, 0.5f};
        pg8::gemm_phase<pg8::EpiResid, pg8::StaticOrder, PG8_ALIGN, PG8_SP2>(F.lds + RING_OFF, g, S, E);
    }
#undef IN
#undef BOTH
}

extern "C" void kernel_launch(void* const* d_in, const int* in_sizes, int n_in, void* d_out, int out_size, void* d_ws, size_t ws_size, hipStream_t stream) {
    static int grid = 0;
    if (grid == 0) {
        if (n_in != 16 || in_sizes[0] != M * D || out_size != M * D || ws_size < WS_END) { fprintf(stderr, "kernel_launch: unexpected shapes (n_in %d, in0 %d, out %d, ws %zu)\n", n_in, n_in > 0 ? in_sizes[0] : -1, out_size, ws_size); grid = -1; return; }
        int dev = 0, cus = 0, per_cu = 0;
        if (hipGetDevice(&dev) != hipSuccess || hipDeviceGetAttribute(&cus, hipDeviceAttributeMultiprocessorCount, dev) != hipSuccess) { grid = -1; return; }
        if (hipFuncSetAttribute((const void*)mk_fwd, hipFuncAttributeMaxDynamicSharedMemorySize, LDS_BYTES) != hipSuccess) { fprintf(stderr, "kernel_launch: hipFuncSetAttribute failed\n"); grid = -1; return; }
        if (hipOccupancyMaxActiveBlocksPerMultiprocessor(&per_cu, (const void*)mk_fwd, NWAVES * 64, LDS_BYTES) != hipSuccess || per_cu < 1) { fprintf(stderr, "kernel_launch: occupancy query says %d blocks per CU\n", per_cu); per_cu = 1; }
        (void)hipGetLastError();
        grid = cus;
        if (grid > 256) grid = 256;
    }
    if (grid < 0) return;
    (void)hipMemsetAsync((char*)d_ws + WS_CTL, 0, CTL_ZERO_BYTES, stream);
    Args a{};
    const float** pp = (const float**)&a.p;
    for (int i = 0; i < 16; ++i) pp[i] = (const float*)d_in[i];
    a.p.out = (float*)d_out; a.p.ws = (unsigned char*)d_ws;
    if (N_LAUNCHES == 1) { a.ph_lo = 0; a.ph_hi = PER_PHASE; a.li = 0; hipLaunchKernelGGL(mk_fwd, dim3(grid), dim3(NWAVES * 64), LDS_BYTES, stream, a); }
    else for (int li = 0; li < PER_PHASE; ++li) { a.ph_lo = li; a.ph_hi = li + 1; a.li = li; hipLaunchKernelGGL(mk_fwd, dim3(grid), dim3(NWAVES * 64), LDS_BYTES, stream, a); }
}
```

```cpp
#include <hip/hip_runtime.h>
#include <cstdio>
#include <cstdint>
#include <hip/hip_bf16.h>
namespace pg8 {
#define PG8_LAS __attribute__((address_space(3)))
typedef unsigned short bf16_t;
typedef short bf16x8 __attribute__((ext_vector_type(8)));
typedef float f32x4 __attribute__((ext_vector_type(4)));
typedef unsigned u32x4 __attribute__((ext_vector_type(4)));
constexpr int BM = 256, BK = 64, HALF = 128, HTB = HALF * BK * 2  , STAGE_BYTES = 8 * HTB, NXCD = 8;

__host__ __device__ __forceinline__ int lds_byte(int r, int c) { const int st = (r >> 4) * 2 + (c >> 5), rr = r & 15, cc = c & 31, ob = rr * 64 + cc * 2; return st * 1024 + (ob ^ (((ob >> 9) & 1) << 5)); }
__host__ __device__ __forceinline__ void stage_rc(int b, int& R, int& C) { const int st = b / 1024, sb = b % 1024, swz = sb ^ (((sb >> 9) & 1) << 5); R = (st >> 1) * 16 + swz / 64; C = (st & 1) * 32 + (swz % 64) / 2; }
__host__ __device__ __forceinline__ int perm32(int rho) { const int n = rho >> 4, i = rho & 15; return 8 * (i >> 2) + 4 * n + (i & 3); }

struct Unit { int pm, pn, idx; };
struct Gemm { const bf16_t* A; const bf16_t* Bt; int M, N, K; size_t bstride; };

struct StaticOrder {
    int nM, nN, nwg, G, c, WGM, ROT;
    __host__ __device__ void init(int M, int N, int G_, int c_, int wgm = 8, int rot = 0) { nM = M / BM; nN = N / BM; nwg = nM * nN; G = G_; c = c_; WGM = wgm; ROT = (G_ == 256) ? rot : 0; }
    __host__ __device__ __forceinline__ int slot(int i) const { const int r = (ROT >> (8 * (i & 3))) & 31; return r ? ((((c >> 3) + r) & 31) << 3) + (c & 7) : c; }
    __host__ __device__ __forceinline__ bool next(int i, Unit& u) const {
        const long L = (long)i * G + slot(i); if (L >= nwg) return false;
        int wgid = (int)L; { const int q = nwg / NXCD, r = nwg % NXCD, xcd = wgid % NXCD, off = wgid / NXCD; wgid = (xcd < r ? xcd * (q + 1) : r * (q + 1) + (xcd - r) * q) + off; }
        const int nig = WGM * nN, gid = wgid / nig, fm = gid * WGM, gsz = (nM - fm) < WGM ? (nM - fm) : WGM;
        u.pm = fm + ((wgid % nig) % gsz); u.pn = (wgid % nig) / gsz; u.idx = i; return true;
    }
    __device__ __forceinline__ void a_ready(const Unit&) const {}
    __device__ __forceinline__ void done(const Unit&) const {}
};

__device__ __forceinline__ unsigned cvt_pk_bf16(float lo, float hi) { unsigned r; asm volatile("v_cvt_pk_bf16_f32 %0, %1, %2" : "=v"(r) : "v"(lo), "v"(hi)); return r; }
typedef float f32x2 __attribute__((ext_vector_type(2)));
__device__ __forceinline__ float sigmoid_f(float x) { return __builtin_amdgcn_rcpf(1.0f + __builtin_amdgcn_exp2f(-1.4426950408889634f * x)); }
__device__ __forceinline__ float silu_f(float x) { return x * sigmoid_f(x); }
__device__ __forceinline__ float bf_lo(unsigned w) { return __builtin_bit_cast(float, w << 16); }
__device__ __forceinline__ float bf_hi(unsigned w) { return __builtin_bit_cast(float, w & 0xffff0000u); }
constexpr int EPT_OFF = 131072;
struct EpiTab {
    float v[6];
    template <int NA> __device__ __forceinline__ void store(PG8_LAS float* tab, int npairs) const { const int t = threadIdx.x;
#pragma unroll
        for (int k = 0; k < 6; ++k) { const int p = 2 * k + (t >> 8), a = p % NA; float x = v[k];
            if (a == 0) x = __builtin_amdgcn_rsqf(x * (1.0f / 1024.0f) + 1e-6f); else if (a == 2) x = 1.0f - x;
            if (p < npairs) tab[p * 256 + (t & 255)] = x; } }
};
template <bool TAB> struct EpiSwiGLU {
    static constexpr bool PERM = true, AFTER_DRAIN = false;
    bf16_t* O; int ldc; PG8_LAS float* tab; int npairs; EpiTab tv;
    __device__ __forceinline__ void post_prologue() const { if constexpr (TAB) tv.store<2>(tab, npairs); }
    __device__ __forceinline__ void operator()(const f32x4 (&acc)[2][2][4][2], const Unit& u, int wr, int wc, int fr, int fq) const {
        const int row0 = u.pm * BM + wr * 64 + fr, col0 = u.pn * HALF + wc * 32 + 8 * fq;
        const float NL2E = -1.4426950408889634f;
        const PG8_LAS float* t = tab + u.idx * 512;
        f32x2 bg[2][2], bu[2][2];
        if constexpr (TAB) {
#pragma unroll
            for (int n = 0; n < 2; ++n) { const f32x4 g4 = *(const PG8_LAS f32x4*)(t + 256 + wc * 32 + 8 * fq + 4 * n), u4 = *(const PG8_LAS f32x4*)(t + 256 + HALF + wc * 32 + 8 * fq + 4 * n);
                bg[n][0] = (f32x2){g4[0], g4[1]}; bg[n][1] = (f32x2){g4[2], g4[3]}; bu[n][0] = (f32x2){u4[0], u4[1]}; bu[n][1] = (f32x2){u4[2], u4[3]}; }
        }
#pragma unroll
        for (int ai = 0; ai < 2; ++ai)
#pragma unroll
            for (int m = 0; m < 4; ++m) { const int row = row0 + ai * HALF + m * 16; bf16_t* rowp = O + (size_t)row * ldc + col0;
                float rs = 1.0f; if constexpr (TAB) rs = t[wr * 64 + fr + ai * HALF + m * 16];
                f32x2 h[4];
#pragma unroll
                for (int n = 0; n < 2; ++n)
#pragma unroll
                    for (int p = 0; p < 2; ++p) { const f32x2 ag = {acc[ai][0][m][n][2 * p], acc[ai][0][m][n][2 * p + 1]}, au = {acc[ai][1][m][n][2 * p], acc[ai][1][m][n][2 * p + 1]};
                        f32x2 g = ag, uu = au; if constexpr (TAB) { g = ag * rs + bg[n][p]; uu = au * rs + bu[n][p]; }
                        const f32x2 tt = g * NL2E;
                        f32x2 d; d.x = __builtin_amdgcn_exp2f(tt.x); d.y = __builtin_amdgcn_exp2f(tt.y); d = d + 1.0f;
                        f32x2 r; r.x = __builtin_amdgcn_rcpf(d.x); r.y = __builtin_amdgcn_rcpf(d.y);
                        h[n * 2 + p] = (g * r) * uu; }
                u32x4 w; w.x = cvt_pk_bf16(h[0].x, h[0].y); w.y = cvt_pk_bf16(h[1].x, h[1].y); w.z = cvt_pk_bf16(h[2].x, h[2].y); w.w = cvt_pk_bf16(h[3].x, h[3].y);
                *(u32x4*)rowp = w; }
    }
};
template <int MODE> struct EpiResid {
    static constexpr bool PERM = true, AFTER_DRAIN = false;
    const float* basef; const bf16_t* baseb; bf16_t* outb; float* outf; const float* gate; int gstride; float sc; float* ss;
    __device__ __forceinline__ void post_prologue() const {}
    __device__ __forceinline__ void operator()(const f32x4 (&acc)[2][2][4][2], const Unit& u, int wr, int wc, int fr, int fq) const {
        const int row0 = u.pm * BM + wr * 64 + fr, col0 = u.pn * BM + wc * 32 + 8 * fq;
        const float* gp = gate + (size_t)(u.pm >= 32 ? gstride : 0) + col0;
        f32x4 gv[2][2];
#pragma unroll
        for (int bj = 0; bj < 2; ++bj)
#pragma unroll
            for (int n = 0; n < 2; ++n) gv[bj][n] = *(const f32x4*)(gp + bj * HALF + 4 * n) * sc;
#pragma unroll
        for (int ai = 0; ai < 2; ++ai) {
            f32x4 bs[4][2][2];
#pragma unroll
            for (int m = 0; m < 4; ++m) { const size_t off = (size_t)(row0 + ai * HALF + m * 16) * 1024 + col0;
#pragma unroll
                for (int bj = 0; bj < 2; ++bj) {
                    if (MODE == 0) { bs[m][bj][0] = __builtin_nontemporal_load((const f32x4*)(basef + off + bj * HALF)); bs[m][bj][1] = __builtin_nontemporal_load((const f32x4*)(basef + off + bj * HALF + 4)); }
                    else { const u32x4 w = *(const u32x4*)(baseb + off + bj * HALF);
                        bs[m][bj][0] = (f32x4){bf_lo(w.x), bf_hi(w.x), bf_lo(w.y), bf_hi(w.y)}; bs[m][bj][1] = (f32x4){bf_lo(w.z), bf_hi(w.z), bf_lo(w.w), bf_hi(w.w)}; } } }
#pragma unroll
            for (int m = 0; m < 4; ++m) { const int row = row0 + ai * HALF + m * 16; const size_t off = (size_t)row * 1024 + col0; float sq = 0.f;
#pragma unroll
                for (int bj = 0; bj < 2; ++bj) { const f32x4 v0 = bs[m][bj][0] + gv[bj][0] * acc[ai][bj][m][0], v1 = bs[m][bj][1] + gv[bj][1] * acc[ai][bj][m][1];
                    if (MODE == 2) { *(f32x4*)(outf + off + bj * HALF) = v0; *(f32x4*)(outf + off + bj * HALF + 4) = v1; }
                    else { u32x4 w; w.x = cvt_pk_bf16(v0[0], v0[1]); w.y = cvt_pk_bf16(v0[2], v0[3]); w.z = cvt_pk_bf16(v1[0], v1[1]); w.w = cvt_pk_bf16(v1[2], v1[3]);
                        *(u32x4*)(outb + off + bj * HALF) = w;
                        sq += (v0[0] * v0[0] + v0[1] * v0[1]) + (v0[2] * v0[2] + v0[3] * v0[3]) + (v1[0] * v1[0] + v1[1] * v1[1]) + (v1[2] * v1[2] + v1[3] * v1[3]); } }
                if (MODE != 2) { sq += __shfl_xor(sq, 16); sq += __shfl_xor(sq, 32); if (fq == 0) atomicAdd(ss + row, sq); } }
            asm volatile("" ::: "memory");
        }
    }
};
struct EpiMixIn {
    static constexpr bool PERM = true, AFTER_DRAIN = false;
    bf16_t* O; PG8_LAS float* tab; int npairs; EpiTab tv;
    __device__ __forceinline__ void post_prologue() const { tv.store<3>(tab, npairs); }
    __device__ __forceinline__ void operator()(const f32x4 (&acc)[2][2][4][2], const Unit& u, int wr, int wc, int fr, int fq) const {
        const int row0 = u.pm * BM + wr * 64 + fr, col0 = u.pn * BM + wc * 32 + 8 * fq;
        const int kind = (u.pn < 2) ? 1 : (u.pn < 6) ? 2 : (u.pn < 8) ? 0 : (u.pn < 10) ? 1 : 0;
        const float L2E = 1.4426950408889634f;
        const PG8_LAS float* t = tab + u.idx * 768;
        f32x2 oml[2][4], bv[2][4];
#pragma unroll
        for (int bj = 0; bj < 2; ++bj)
#pragma unroll
            for (int n = 0; n < 2; ++n) { const int c = wc * 32 + 8 * fq + bj * HALF + 4 * n;
                const f32x4 b4 = *(const PG8_LAS f32x4*)(t + 256 + c), l4 = *(const PG8_LAS f32x4*)(t + 512 + c);
                bv[bj][2 * n] = (f32x2){b4[0], b4[1]}; bv[bj][2 * n + 1] = (f32x2){b4[2], b4[3]};
                oml[bj][2 * n] = (f32x2){l4[0], l4[1]}; oml[bj][2 * n + 1] = (f32x2){l4[2], l4[3]}; }
        const float sg = (kind == 2) ? L2E : -L2E;
#pragma unroll
        for (int ai = 0; ai < 2; ++ai)
#pragma unroll
            for (int m = 0; m < 4; ++m) { const int row = row0 + ai * HALF + m * 16; bf16_t* rowp = O + (size_t)row * 3328 + col0;
                const float rs = t[wr * 64 + fr + ai * HALF + m * 16];
#pragma unroll
                for (int bj = 0; bj < 2; ++bj) { f32x2 h[4];
#pragma unroll
                    for (int q = 0; q < 4; ++q) { const f32x2 a = {acc[ai][bj][m][q >> 1][2 * (q & 1)], acc[ai][bj][m][q >> 1][2 * (q & 1) + 1]};
                        const f32x2 z = a * rs + bv[bj][q];
                        if (kind == 0) h[q] = z;
                        else { const f32x2 tt = z * sg;
                            f32x2 d; d.x = __builtin_amdgcn_exp2f(tt.x); d.y = __builtin_amdgcn_exp2f(tt.y); d = d + 1.0f;
                            f32x2 r; r.x = __builtin_amdgcn_rcpf(d.x); r.y = __builtin_amdgcn_rcpf(d.y);
                            if (kind == 1) h[q] = z * r;
                            else { const f32x2 f = 1.0f - oml[bj][q] * r;
                                f32x2 lg; lg.x = __builtin_amdgcn_logf(f.x); lg.y = __builtin_amdgcn_logf(f.y); h[q] = lg * 0.6931471805599453f; } } }
                    u32x4 w; w.x = cvt_pk_bf16(h[0].x, h[0].y); w.y = cvt_pk_bf16(h[1].x, h[1].y); w.z = cvt_pk_bf16(h[2].x, h[2].y); w.w = cvt_pk_bf16(h[3].x, h[3].y);
                    *(u32x4*)(rowp + bj * HALF) = w; } }
    }
};
template <class Epi, class Sched, bool ALIGN_EPI = false, bool SP2 = false>
__device__ __forceinline__ void gemm_phase(PG8_LAS unsigned char* lds, const Gemm g, const Sched& S, const Epi& E) {
    const int tid = threadIdx.x, wid = __builtin_amdgcn_readfirstlane(tid >> 6), lane = tid & 63, wr = wid >> 2, wc = wid & 3, fr = lane & 15, fq = lane >> 4;
    const int K = g.K, nt = K / BK;
    unsigned voffA[2], voffB[2];
#pragma unroll
    for (int i = 0; i < 2; ++i) { int R, C; stage_rc(tid * 16 + i * 8192, R, C); const int Rb = Epi::PERM ? ((R & ~31) + perm32(R & 31)) : R;
        voffA[i] = (unsigned)(R * K + C) * 2u; voffB[i] = (unsigned)(Rb * K + C) * 2u; }
    const size_t kstep = (size_t)(BK * 2);
    const size_t hstep = (size_t)HALF * K * 2;
    const size_t tstep = 2 * hstep;
    const unsigned ldsw = (unsigned)wid * 1024u;
    const int aoff = lds_byte(wr * 64 + fr, fq * 8), boff = lds_byte(wc * 32 + fr, fq * 8);
#define PG8_SA(b, h) (((b) * 2 + (h)) * HTB)
#define PG8_SB(b, h) ((4 + (b) * 2 + (h)) * HTB)
#define PG8_STAGE(bufoff, gbase, voff) do { _Pragma("unroll") for (int _i = 0; _i < 2; ++_i) \
        __builtin_amdgcn_global_load_lds((const unsigned*)((const char*)(gbase) + (voff)[_i]), (PG8_LAS unsigned*)(lds + (bufoff) + ldsw + _i * 8192), 16, 0, 0); } while (0)
#define PG8_LDA(dst, b, h) do { _Pragma("unroll") for (int m = 0; m < 4; ++m) _Pragma("unroll") for (int k = 0; k < 2; ++k) dst[m][k] = *(const PG8_LAS bf16x8*)(lds + PG8_SA(b, h) + aoff + m * 2048 + k * 1024); } while (0)
#define PG8_LDB(dst, b, h) do { _Pragma("unroll") for (int n = 0; n < 2; ++n) _Pragma("unroll") for (int k = 0; k < 2; ++k) dst[n][k] = *(const PG8_LAS bf16x8*)(lds + PG8_SB(b, h) + boff + n * 2048 + k * 1024); } while (0)
#define PG8_MMA(ai, bj, At, Bt) do { __builtin_amdgcn_s_setprio(1); _Pragma("unroll") for (int m = 0; m < 4; ++m) _Pragma("unroll") for (int n = 0; n < 2; ++n) _Pragma("unroll") for (int k = 0; k < 2; ++k) \
        acc[ai][bj][m][n] = __builtin_amdgcn_mfma_f32_16x16x32_bf16(Bt[n][k], At[m][k], acc[ai][bj][m][n], 0, 0, 0); __builtin_amdgcn_s_setprio(0); } while (0)
#define PG8_WAIT_V(n) asm volatile("s_waitcnt vmcnt(" #n ")" ::: "memory")
#define PG8_WAIT_L(n) asm volatile("s_waitcnt lgkmcnt(" #n ")" ::: "memory")
#define PG8_BAR __builtin_amdgcn_s_barrier()
#define PG8_SCHED __builtin_amdgcn_sched_barrier(0)
    Unit cur, nxt; int ui = 0;
    if (!S.next(0, cur)) return;
    f32x4 acc[2][2][4][2];
#pragma unroll
    for (int a = 0; a < 2; ++a)
#pragma unroll
        for (int b = 0; b < 2; ++b)
#pragma unroll
            for (int m = 0; m < 4; ++m)
#pragma unroll
                for (int n = 0; n < 2; ++n) { f32x2 z0, z1; asm volatile("v_mov_b64 %0, 0" : "=v"(z0)); asm volatile("v_mov_b64 %0, 0" : "=v"(z1)); acc[a][b][m][n] = (f32x4){z0.x, z0.y, z1.x, z1.y}; }
    bf16x8 At[4][2], B0[2][2], B1[2][2];
    const char* cA = (const char*)g.A + (size_t)cur.pm * tstep; const char* cB = (const char*)g.Bt + (size_t)cur.pn * tstep + (cur.pm >= 32 ? g.bstride : (size_t)0);
    S.a_ready(cur);
    if constexpr (SP2) {
        PG8_STAGE(PG8_SB(0, 0), cB, voffB); PG8_STAGE(PG8_SB(0, 1), cB + hstep, voffB); PG8_STAGE(PG8_SA(0, 0), cA, voffA); PG8_STAGE(PG8_SA(0, 1), cA + hstep, voffA);
        PG8_STAGE(PG8_SB(1, 0), cB + kstep, voffB); PG8_STAGE(PG8_SA(1, 0), cA + kstep, voffA); PG8_STAGE(PG8_SB(1, 1), cB + hstep + kstep, voffB);
        if (wr == 1) PG8_BAR;
        PG8_WAIT_V(8); PG8_BAR;
        PG8_WAIT_V(6); PG8_BAR;
    } else {
        PG8_STAGE(PG8_SB(0, 0), cB, voffB); PG8_STAGE(PG8_SA(0, 0), cA, voffA); PG8_STAGE(PG8_SB(0, 1), cB + hstep, voffB); PG8_STAGE(PG8_SA(0, 1), cA + hstep, voffA);
        if (wr == 1) PG8_BAR;
        PG8_WAIT_V(4); PG8_BAR;
        PG8_STAGE(PG8_SB(1, 0), cB + kstep, voffB); PG8_STAGE(PG8_SA(1, 0), cA + kstep, voffA); PG8_STAGE(PG8_SB(1, 1), cB + hstep + kstep, voffB);
        PG8_WAIT_V(6); PG8_BAR;
    }
    E.post_prologue();
    for (;;) {
        const bool has_next = S.next(ui + 1, nxt);
        const char* nA = has_next ? (const char*)g.A + (size_t)nxt.pm * tstep : cA + (size_t)(nt - 2) * kstep; const char* nB = has_next ? (const char*)g.Bt + (size_t)nxt.pn * tstep + (nxt.pm >= 32 ? g.bstride : (size_t)0) : cB + (size_t)(nt - 2) * kstep;
        for (int t = 0; t < nt; t += 2) {
            const bool last = (t == nt - 2);
            const char* a1 = cA + (size_t)(t + 1) * kstep;
            const char* a2 = last ? nA : cA + (size_t)(t + 2) * kstep; const char* b2 = last ? nB : cB + (size_t)(t + 2) * kstep;
            const char* a3 = a2 + kstep; const char* b3 = b2 + kstep;
            if (last && has_next) S.a_ready(nxt);
            if constexpr (SP2) {
            PG8_LDB(B0, 0, 0); PG8_LDB(B1, 0, 1); PG8_SCHED; PG8_LDA(At, 0, 0); PG8_STAGE(PG8_SA(1, 1), a1 + hstep, voffA);
            PG8_WAIT_V(8); PG8_WAIT_L(0); PG8_BAR; PG8_MMA(0, 0, At, B0); PG8_MMA(0, 1, At, B1); PG8_BAR; PG8_SCHED;
            PG8_LDA(At, 0, 1); PG8_STAGE(PG8_SB(0, 0), b2, voffB); PG8_STAGE(PG8_SB(0, 1), b2 + hstep, voffB); PG8_STAGE(PG8_SA(0, 0), a2, voffA);
            PG8_WAIT_V(8); PG8_WAIT_L(0); PG8_BAR; PG8_MMA(1, 0, At, B0); PG8_MMA(1, 1, At, B1); PG8_BAR; PG8_SCHED;
            PG8_LDB(B0, 1, 0); PG8_LDB(B1, 1, 1); PG8_SCHED; PG8_LDA(At, 1, 0); PG8_STAGE(PG8_SA(0, 1), a2 + hstep, voffA);
            PG8_WAIT_V(8); PG8_WAIT_L(0); PG8_BAR; PG8_MMA(0, 0, At, B0); PG8_MMA(0, 1, At, B1); PG8_BAR; PG8_SCHED;
            PG8_LDA(At, 1, 1); PG8_STAGE(PG8_SB(1, 0), b3, voffB); PG8_STAGE(PG8_SB(1, 1), b3 + hstep, voffB); PG8_STAGE(PG8_SA(1, 0), a3, voffA);
            PG8_WAIT_V(8); PG8_WAIT_L(0); PG8_BAR; PG8_MMA(1, 0, At, B0); PG8_MMA(1, 1, At, B1); PG8_BAR; PG8_SCHED;
            } else {
            PG8_LDB(B0, 0, 0); PG8_SCHED; PG8_LDA(At, 0, 0); PG8_STAGE(PG8_SA(1, 1), a1 + hstep, voffA);
            PG8_WAIT_L(8); PG8_BAR; PG8_WAIT_L(0); PG8_MMA(0, 0, At, B0); PG8_BAR; PG8_SCHED;
            PG8_LDB(B1, 0, 1); PG8_STAGE(PG8_SB(0, 0), b2, voffB);
            PG8_BAR; PG8_WAIT_L(0); PG8_MMA(0, 1, At, B1); PG8_BAR;
            PG8_LDA(At, 0, 1); PG8_STAGE(PG8_SA(0, 0), a2, voffA);
            PG8_BAR; PG8_WAIT_L(0); PG8_MMA(1, 0, At, B0); PG8_BAR; PG8_SCHED;
            PG8_STAGE(PG8_SB(0, 1), b2 + hstep, voffB);
            PG8_WAIT_V(6); PG8_BAR; PG8_MMA(1, 1, At, B1); PG8_BAR;
            PG8_LDB(B0, 1, 0); PG8_SCHED; PG8_LDA(At, 1, 0); PG8_STAGE(PG8_SA(0, 1), a2 + hstep, voffA);
            PG8_WAIT_L(8); PG8_BAR; PG8_WAIT_L(0); PG8_MMA(0, 0, At, B0); PG8_BAR; PG8_SCHED;
            PG8_LDB(B1, 1, 1); PG8_STAGE(PG8_SB(1, 0), b3, voffB);
            PG8_BAR; PG8_WAIT_L(0); PG8_MMA(0, 1, At, B1); PG8_BAR;
            PG8_LDA(At, 1, 1); PG8_STAGE(PG8_SA(1, 0), a3, voffA);
            PG8_BAR; PG8_WAIT_L(0); PG8_MMA(1, 0, At, B0); PG8_BAR; PG8_SCHED;
            PG8_STAGE(PG8_SB(1, 1), b3 + hstep, voffB);
            PG8_WAIT_V(6); PG8_BAR; PG8_MMA(1, 1, At, B1); PG8_BAR;
            }
        }
        if constexpr (ALIGN_EPI) { if (wr == 0) PG8_BAR; }
        if constexpr (!Epi::AFTER_DRAIN) { E(acc, cur, wr, wc, fr, fq); S.done(cur); }
        if (!has_next) break;
#pragma unroll
        for (int a = 0; a < 2; ++a)
#pragma unroll
            for (int b = 0; b < 2; ++b)
#pragma unroll
                for (int m = 0; m < 4; ++m)
#pragma unroll
                    for (int n = 0; n < 2; ++n) { f32x2 z0, z1; asm volatile("v_mov_b64 %0, 0" : "=v"(z0)); asm volatile("v_mov_b64 %0, 0" : "=v"(z1)); acc[a][b][m][n] = (f32x4){z0.x, z0.y, z1.x, z1.y}; }
        cur = nxt; cA = nA; cB = nB; ++ui;
        if constexpr (ALIGN_EPI) { if (wr == 1) PG8_BAR; }
    }
    PG8_WAIT_V(0);
    if constexpr (!ALIGN_EPI) { if (wr == 0) PG8_BAR; }
    PG8_BAR;
    if constexpr (Epi::AFTER_DRAIN) { E.fused(acc, cur, wr, wc, fr, fq, lds, wid, lane); S.done(cur); }
#undef PG8_SA
#undef PG8_SB
#undef PG8_STAGE
#undef PG8_LDA
#undef PG8_LDB
#undef PG8_MMA
#undef PG8_WAIT_V
#undef PG8_WAIT_L
#undef PG8_BAR
#undef PG8_SCHED
}
}

#ifndef PG8_SP2
#define PG8_SP2 true
#endif
#ifndef PG8_ALIGN
#define PG8_ALIGN true
#endif
#define GAS __attribute__((address_space(1)))
#define LAS __attribute__((address_space(3)))
typedef unsigned short bf16;
typedef unsigned v4u __attribute__((ext_vector_type(4)));
typedef float f32x4 __attribute__((ext_vector_type(4)));
typedef short bf16x8 __attribute__((ext_vector_type(8)));
typedef GAS unsigned gu32;
typedef GAS unsigned long long gu64;
#define RLX_AGENT __ATOMIC_RELAXED, __HIP_MEMORY_SCOPE_AGENT
#define LDS_WAIT() asm volatile("s_waitcnt lgkmcnt(0)" ::: "memory")
#define VM_WAIT() asm volatile("s_waitcnt vmcnt(0)" ::: "memory")
__device__ __forceinline__ unsigned long long rt() { return __builtin_amdgcn_s_memrealtime(); }
__device__ __forceinline__ unsigned f2bf(float f) { unsigned u = __builtin_bit_cast(unsigned, f); return (u + 0x7fffu + ((u >> 16) & 1u)) >> 16; }
__device__ __forceinline__ unsigned pk2(float lo, float hi) { return f2bf(lo) | (f2bf(hi) << 16); }

#define XB_TMO      128
#define XB_XCNT(j)  (256  + 64 * (j))
#define XB_XSUB(j)  (1280 + 64 * (j))
#define XB_XGEN(j)  (2304 + 64 * (j))
#define XB_TOP      3328
#define XB_TOPGEN   3392
#define XB_LSUB(j)  (3456 + 64 * (j))
#define XB_LGEN(j)  (4480 + 64 * (j))
#define XCD_BAR_WORDS 5504
#define XB_SPIN_CAP (1u << 18)

__device__ __forceinline__ unsigned xb_ld(unsigned* p)              { return __hip_atomic_load(p, __ATOMIC_RELAXED, __HIP_MEMORY_SCOPE_AGENT); }
__device__ __forceinline__ unsigned xb_add(unsigned* p, unsigned v) { return __hip_atomic_fetch_add(p, v, __ATOMIC_RELAXED, __HIP_MEMORY_SCOPE_AGENT); }
__device__ __forceinline__ unsigned xb_xcc_id() { return (unsigned)__builtin_amdgcn_s_getreg((3 << 11) | 20) & 0xFu; }
#define XB_SPIN(cond, bar) do { unsigned _sp = 0; while (cond) { __builtin_amdgcn_s_sleep(1); \
    if ((++_sp & 255u) == 0u) { if (xb_ld(&(bar)[XB_TMO])) break; if (_sp > XB_SPIN_CAP) { atomicAdd(&(bar)[XB_TMO], 1u); break; } } } } while (0)

struct XcdBarrier {
    unsigned* bar; unsigned x;
    volatile LAS unsigned* st;
};

__device__ __forceinline__ XcdBarrier xcd_barrier_post(unsigned* bar, volatile LAS unsigned* st) {
    XcdBarrier b; b.bar = bar; b.x = xb_xcc_id(); b.st = st;
    if (threadIdx.x == 0) st[4] = xb_add(&bar[XB_XCNT(b.x)], 1u);
    return b;
}
__device__ __forceinline__ void xcd_barrier_complete(unsigned* bar, unsigned x, unsigned& nloc, unsigned& nx, unsigned& balanced) {
    const unsigned G = gridDim.x * gridDim.y * gridDim.z;
    unsigned sum, cnt, mine, sp = 0u, even;
    for (;;) {
        sum = 0u; cnt = 0u; mine = 0u; even = 1u;
#pragma unroll
        for (unsigned j = 0; j < 16; ++j) { const unsigned c = xb_ld(&bar[XB_XCNT(j)]); sum += c; cnt += (c > 0u) ? 1u : 0u; mine = (j == x) ? c : mine; even &= (j < 8u ? c * 8u == G : c == 0u) ? 1u : 0u; }
        if (sum == G) break;
        __builtin_amdgcn_s_sleep(1);
        if ((++sp & 255u) == 0u) { if (xb_ld(&bar[XB_TMO])) break; if (sp > XB_SPIN_CAP) { atomicAdd(&bar[XB_TMO], 1u); break; } }
    }
    nloc = mine > 0u ? mine : 1u; nx = cnt > 0u ? cnt : 1u;
    balanced = (sum == G && even && cnt == 8u) ? 1u : 2u;
}

__device__ __forceinline__ void xcd_barrier(const XcdBarrier& b) {
    asm volatile("s_waitcnt vmcnt(0)" ::: "memory");
    __syncthreads();
    if (threadIdx.x == 0) {
        unsigned* bar = b.bar;
        __builtin_amdgcn_s_waitcnt(0);
        unsigned nloc = b.st[0], nx = b.st[1];
        if (nloc == 0u) { unsigned bal; xcd_barrier_complete(bar, b.x, nloc, nx, bal); b.st[0] = nloc; b.st[1] = nx; b.st[5] = bal; }
        const unsigned old = xb_add(&bar[XB_XSUB(b.x)], 1u);
        const unsigned gen = old / nloc;
        if (old + 1u == (gen + 1u) * nloc) {
            __builtin_amdgcn_fence(__ATOMIC_RELEASE, "agent");
            asm volatile("s_waitcnt vmcnt(0)" ::: "memory");
            const unsigned og = xb_add(&bar[XB_TOP], 1u);
            const unsigned tg = og / nx;
            if (og + 1u == (tg + 1u) * nx) {
#pragma unroll
                for (unsigned j = 0; j < 16; ++j) (void)__hip_atomic_fetch_add(&bar[XB_XGEN(j)], 1u, __ATOMIC_RELAXED, __HIP_MEMORY_SCOPE_AGENT);
            }
        }
        XB_SPIN(xb_ld(&bar[XB_XGEN(b.x)]) == gen, bar);
        __builtin_amdgcn_fence(__ATOMIC_ACQUIRE, "agent");
        asm volatile("s_waitcnt vmcnt(0)" ::: "memory");
    }
    __syncthreads();
}
__device__ __forceinline__ void xcd_local_barrier(const XcdBarrier& b) {
    asm volatile("s_waitcnt vmcnt(0)" ::: "memory");
    __syncthreads();
    if (threadIdx.x == 0) {
        unsigned* bar = b.bar;
        __builtin_amdgcn_s_waitcnt(0);
        const unsigned nloc = b.st[0];
        const unsigned old = xb_add(&bar[XB_LSUB(b.x)], 1u);
        const unsigned gen = old / nloc;
        if (old + 1u == (gen + 1u) * nloc) xb_add(&bar[XB_LGEN(b.x)], 1u);
        else XB_SPIN(xb_ld(&bar[XB_LGEN(b.x)]) == gen, bar);
        __builtin_amdgcn_fence(__ATOMIC_ACQUIRE, "agent");
        asm volatile("s_waitcnt vmcnt(0)" ::: "memory");
    }
    __syncthreads();
}
using pg8::silu_f; using pg8::sigmoid_f;
__device__ __forceinline__ void xcd_barrier_arrive(const XcdBarrier& b) {
    asm volatile("s_waitcnt vmcnt(0)" ::: "memory");
    __syncthreads();
    if (threadIdx.x == 0) {
        unsigned* bar = b.bar;
        __builtin_amdgcn_s_waitcnt(0);
        unsigned nloc = b.st[0], nx = b.st[1];
        if (nloc == 0u) { unsigned bal; xcd_barrier_complete(bar, b.x, nloc, nx, bal); b.st[0] = nloc; b.st[1] = nx; b.st[5] = bal; }
        const unsigned old = xb_add(&bar[XB_XSUB(b.x)], 1u);
        const unsigned gen = old / nloc;
        if (old + 1u == (gen + 1u) * nloc) {
            __builtin_amdgcn_fence(__ATOMIC_RELEASE, "agent");
            asm volatile("s_waitcnt vmcnt(0)" ::: "memory");
            const unsigned og = xb_add(&bar[XB_TOP], 1u);
            const unsigned tg = og / nx;
            if (og + 1u == (tg + 1u) * nx) {
#pragma unroll
                for (unsigned j = 0; j < 16; ++j) (void)__hip_atomic_fetch_add(&bar[XB_XGEN(j)], 1u, __ATOMIC_RELAXED, __HIP_MEMORY_SCOPE_AGENT);
            }
        }
        b.st[3] = gen;
    }
}
__device__ __forceinline__ void xcd_barrier_wait(const XcdBarrier& b) {
    asm volatile("s_waitcnt vmcnt(0)" ::: "memory");
    __syncthreads();
    if (threadIdx.x == 0) {
        unsigned* bar = b.bar;
        const unsigned g = b.st[3];
        XB_SPIN(xb_ld(&bar[XB_XGEN(b.x)]) == g, bar);
        __builtin_amdgcn_fence(__ATOMIC_ACQUIRE, "agent");
        asm volatile("s_waitcnt vmcnt(0)" ::: "memory");
    }
    __syncthreads();
}

constexpr int NWAVES = 8;
#ifndef MK_N_LAUNCHES
#define MK_N_LAUNCHES 1
#endif
constexpr int PER_PHASE = 11;
#ifndef WG_IN
#define WG_IN 4
#endif
#ifndef WG_OUT
#define WG_OUT 4
#endif
constexpr int N_LAUNCHES = MK_N_LAUNCHES;

constexpr int T = 8192, D = 1024, FF = 2816, M = 2 * T, DIN = 3328, NMOD = 9 * D;
constexpr float EPS = 1e-6f;
constexpr int ZC_Q = 0, ZC_GF = 512, ZC_GB = 1024, ZC_V = 1536, ZC_GATE = 2048, ZC_AQ = 2560, ZC_AK = 3072, ZC_AV = 3200;

constexpr size_t MiB = 1u << 20;
constexpr size_t WS_CTL = 0, CTL_ZERO_BYTES = 448 * 1024;
constexpr size_t WS_MODS = 64 * 1024;
constexpr size_t WS_SS1 = 192 * 1024, WS_SS2 = 256 * 1024;
constexpr size_t WS_BMI = 320 * 1024;
constexpr size_t WS_B2I = 384 * 1024;
constexpr size_t WS_LB = 1 * MiB;
constexpr size_t WS_W1I = 2 * MiB, WS_W1O = 13 * MiB, WS_W2O = 19 * MiB, WS_WMO = 25 * MiB, WS_WMI = 27 * MiB, WS_W2I = 40 * MiB;
constexpr size_t WS_X = 62 * MiB;
constexpr size_t WS_H = 94 * MiB;
constexpr size_t WS_MIX = WS_H;
constexpr size_t WS_ZH = 126 * MiB;
constexpr size_t WS_SLOC = 230 * MiB;
constexpr size_t WS_SIN = 246 * MiB;
constexpr size_t WS_DSEG = 254 * MiB;
constexpr size_t WS_END = 256 * MiB;
static_assert(WS_MODS + 2 * 9216 * 4 <= WS_SS1 && WS_SS1 + 16384 * 4 <= WS_SS2 && WS_SS2 + 16384 * 4 <= WS_BMI && WS_BMI + 2 * 3328 * 4 <= WS_B2I && WS_B2I + 2 * 5632 * 4 <= CTL_ZERO_BYTES, "zeroed region");
static_assert(WS_W1I + (size_t)2 * FF * D * 2 <= WS_W1O && WS_W1O + (size_t)D * FF * 2 <= WS_W2O && WS_W2O + (size_t)D * FF * 2 <= WS_WMO && WS_WMO + (size_t)D * D * 2 <= WS_WMI &&
              WS_WMI + (size_t)2 * DIN * D * 2 <= WS_W2I && WS_W2I + (size_t)4 * FF * D * 2 <= WS_X && WS_X + (size_t)M * D * 2 <= WS_H && WS_H + (size_t)M * D * 2 <= WS_ZH && WS_ZH + (size_t)M * DIN * 2 <= WS_SLOC, "d_ws map");
constexpr int CW_TMO = 0, CW_CODE = 1, CW_BAR = 4096;

constexpr int RING_OFF = 0, RING_BYTES = 147456;
constexpr int LDSCTL_OFF = RING_BYTES, MISC_OFF = LDSCTL_OFF + 320;
constexpr int LDS_BYTES = 151552;
static_assert(MISC_OFF + 128 <= LDS_BYTES, "LDS map");

struct Frame {
    LAS unsigned char* lds;
    volatile LAS unsigned* MISC;
    gu32* ctl;
    int tid, lane, wave;
    int vcu, G;
};

__device__ __forceinline__ float wave_sum(float v) {
#pragma unroll
    for (int o = 1; o < 64; o <<= 1) v += __shfl_xor(v, o);
    return v;
}
__device__ __forceinline__ float bf2f(bf16 v) { return __builtin_bit_cast(float, (unsigned)v << 16); }
__device__ __forceinline__ float bflo(unsigned w) { return __builtin_bit_cast(float, w << 16); }
__device__ __forceinline__ float bfhi(unsigned w) { return __builtin_bit_cast(float, w & 0xffff0000u); }

__device__ __forceinline__ void p0_transpose_item(const float* W, int K, int N, bf16* WT, int k0, int n0, int dst_row0, LAS float* scr, int lane) {
#pragma unroll 8
    for (int i = 0; i < 32; ++i) { const int kk = 2 * i + (lane >> 5); scr[kk * 33 + (lane & 31)] = __builtin_nontemporal_load(W + (size_t)(k0 + kk) * N + n0 + (lane & 31)); }
    LDS_WAIT(); asm volatile("" ::: "memory");
    const int c = lane & 7;
#pragma unroll
    for (int j = 0; j < 4; ++j) { const int n = (lane >> 3) + 8 * j; const LAS float* s = scr + (8 * c) * 33 + n;
        v4u o; o.x = pk2(s[0 * 33], s[1 * 33]); o.y = pk2(s[2 * 33], s[3 * 33]); o.z = pk2(s[4 * 33], s[5 * 33]); o.w = pk2(s[6 * 33], s[7 * 33]);
        *(GAS v4u*)(WT + (size_t)(dst_row0 + n) * K + k0 + 8 * c) = o; }
    LDS_WAIT(); asm volatile("" ::: "memory");
}
__device__ __forceinline__ void p0_transpose_mod(const float* W, int K, int N, bf16* WT, size_t bstride_el, int k0, int n0, int dst_row0, LAS float* scr, const LAS float* AB, float* bias, int bias_stride, int lane) {
#pragma unroll 8
    for (int i = 0; i < 32; ++i) { const int kk = 2 * i + (lane >> 5); scr[kk * 33 + (lane & 31)] = __builtin_nontemporal_load(W + (size_t)(k0 + kk) * N + n0 + (lane & 31)); }
    LDS_WAIT(); asm volatile("" ::: "memory");
    const int c = lane & 7;
    float a0[8], a1[8], s0[8], s1[8];
#pragma unroll
    for (int i = 0; i < 8; ++i) { a0[i] = AB[0 * 1024 + k0 + 8 * c + i]; s0[i] = AB[1 * 1024 + k0 + 8 * c + i]; a1[i] = AB[2 * 1024 + k0 + 8 * c + i]; s1[i] = AB[3 * 1024 + k0 + 8 * c + i]; }
#pragma unroll
    for (int j = 0; j < 4; ++j) { const int n = (lane >> 3) + 8 * j; const LAS float* s = scr + (8 * c) * 33 + n;
        float w[8]; float b0 = 0.f, b1 = 0.f;
#pragma unroll
        for (int i = 0; i < 8; ++i) { w[i] = s[i * 33]; b0 += s0[i] * w[i]; b1 += s1[i] * w[i]; }
        v4u o; o.x = pk2(w[0] * a0[0], w[1] * a0[1]); o.y = pk2(w[2] * a0[2], w[3] * a0[3]); o.z = pk2(w[4] * a0[4], w[5] * a0[5]); o.w = pk2(w[6] * a0[6], w[7] * a0[7]);
        *(GAS v4u*)(WT + (size_t)(dst_row0 + n) * K + k0 + 8 * c) = o;
        o.x = pk2(w[0] * a1[0], w[1] * a1[1]); o.y = pk2(w[2] * a1[2], w[3] * a1[3]); o.z = pk2(w[4] * a1[4], w[5] * a1[5]); o.w = pk2(w[6] * a1[6], w[7] * a1[7]);
        *(GAS v4u*)(WT + bstride_el + (size_t)(dst_row0 + n) * K + k0 + 8 * c) = o;
        b0 += __shfl_xor(b0, 1); b0 += __shfl_xor(b0, 2); b0 += __shfl_xor(b0, 4); b1 += __shfl_xor(b1, 1); b1 += __shfl_xor(b1, 2); b1 += __shfl_xor(b1, 4);
        if (c == 0) { atomicAdd(bias + dst_row0 + n, b0); atomicAdd(bias + bias_stride + dst_row0 + n, b1); } }
    LDS_WAIT(); asm volatile("" ::: "memory");
}
__device__ __forceinline__ void p0_transpose_nat(const float* W, int K, int N, bf16* WT, LAS float* scr, int item, int lane) {
    const int nblk = N / 32, kb = item / nblk, nb = item % nblk;
    p0_transpose_item(W, K, N, WT, 64 * kb, 32 * nb, 32 * nb, scr, lane);
}
__device__ __forceinline__ int glu_row(int n0) { const int up = n0 >= FF, nn = n0 - (up ? FF : 0); return 256 * (nn >> 7) + (up ? 128 : 0) + (nn & 127); }
__device__ __forceinline__ void p0_transpose_glu(const float* W, bf16* WT, LAS float* scr, int item, int lane) {
    const int nblk = (2 * FF) / 32, kb = item / nblk, nb = item % nblk, n0 = 32 * nb;
    p0_transpose_item(W, D, 2 * FF, WT, 64 * kb, n0, glu_row(n0), scr, lane);
}
__device__ __forceinline__ int t5_bucket(int rel) {
    const int n = rel < 0 ? -rel : rel; int r = rel > 0 ? 16 : 0;
    if (n < 8) return r + n;
    return r + 8 + (n >= 12) + (n >= 16) + (n >= 23) + (n >= 32) + (n >= 46) + (n >= 64) + (n >= 91);
}

struct Ptrs {
    const float *x, *c, *w_ada, *b_ada, *norm_g, *w1i, *w1o, *w2i, *w2o, *wmi, *wmo, *hlb, *hng, *qkg, *sink, *relb;
    float* out; unsigned char* ws;
};

template <int RW, int SEL> __device__ __forceinline__ void adaln_gemv(Frame& F, const Ptrs& P) {
    float* mods = (float*)(P.ws + WS_MODS);
    constexpr int NKS = 1024 / (8 * RW), NG = SEL == 0 ? 16 : SEL == 1 ? 12 : 8;
    for (int it = blockIdx.x; it < NG * NKS; it += F.G) {
        const int g = it % NG, ks = it / NG, k0 = ks * (8 * RW) + F.wave * RW;
        const int cg = SEL == 0 ? (g < 8 ? g : g + 4) : SEL == 1 ? (g < 4 ? 8 + g : 20 + g) : (g < 4 ? 20 + g : 28 + g);
        f32x4 a0 = {0.f, 0.f, 0.f, 0.f}, a1 = {0.f, 0.f, 0.f, 0.f};
        const float* wp = P.w_ada + (size_t)k0 * NMOD + cg * 256 + 4 * F.lane;
#pragma unroll
        for (int r = 0; r < RW; ++r) { const f32x4 w = __builtin_nontemporal_load((const f32x4*)(wp + (size_t)r * NMOD));
            const float c0 = P.c[k0 + r], c1 = P.c[D + k0 + r];
            a0 += w * silu_f(c0); a1 += w * silu_f(c1); }
        LAS f32x4* red = (LAS f32x4*)F.lds;
        red[(F.wave * 2 + 0) * 64 + F.lane] = a0; red[(F.wave * 2 + 1) * 64 + F.lane] = a1;
        __syncthreads();
        if (F.tid < 128) { const int b = F.tid >> 6, l = F.tid & 63; f32x4 s = {0.f, 0.f, 0.f, 0.f};
#pragma unroll
            for (int w = 0; w < 8; ++w) s += red[(w * 2 + b) * 64 + l];
            if (ks == 0) s += *(const f32x4*)(P.b_ada + cg * 256 + 4 * l);
            float* mp = mods + (size_t)b * NMOD + cg * 256 + 4 * l;
            atomicAdd(mp + 0, s[0]); atomicAdd(mp + 1, s[1]); atomicAdd(mp + 2, s[2]); atomicAdd(mp + 3, s[3]); }
        __syncthreads();
    }
}
__device__ __forceinline__ void phase_p0a(Frame& F, const Ptrs& P) {
    adaln_gemv<8, 0>(F, P);
    if (blockIdx.x == 1 % F.G && F.tid < 64) { float v = fabsf(P.qkg[F.tid] * P.qkg[64 + F.tid]);
#pragma unroll
        for (int o = 1; o < 64; o <<= 1) v = fmaxf(v, __shfl_xor(v, o));
        if (F.tid == 0) *(float*)(P.ws + WS_LB + 8192) = 8.0f * v; }
    if (blockIdx.x == 0) {
        float* lbp = (float*)(P.ws + WS_LB);
        for (int i = F.tid; i < 1024; i += 512) { const int d = i >> 9, c = i & 511; lbp[i] = 1.0f / (1.0f + expf(P.hlb[d * 1024 + 512 + c] - P.hlb[d * 1024 + c])); }
    }
}
__device__ __forceinline__ void phase_p0a_weights(Frame& F, const Ptrs& P, const int part, const int blk0) {
    LAS float* scr = (LAS float*)(F.lds + 16384 + F.wave * 12288);
    constexpr int I_1I = (D / 64) * (2 * FF / 32);
    const int NGW = F.G * NWAVES, split = NGW < I_1I ? NGW : I_1I;
    if (part == 0) { const int it = F.vcu * NWAVES + F.wave; if (it < split) p0_transpose_glu(P.w1i, (bf16*)(P.ws + WS_W1I), scr, it, F.lane); }
    else { const int b0 = blk0 < F.G ? blk0 : 0, nb = F.G - b0;
        if ((int)blockIdx.x >= b0) for (int it = split + ((int)blockIdx.x - b0) * NWAVES + F.wave; it < I_1I; it += nb * NWAVES) p0_transpose_glu(P.w1i, (bf16*)(P.ws + WS_W1I), scr, it, F.lane); }
}
__device__ __forceinline__ void deferred_weights(Frame& F, const Ptrs& P, int part, int widx, int nw) {
    const float* mods = (const float*)(P.ws + WS_MODS);
    const int set = part == 1 ? 2 : 1;
    LAS float* AB = (LAS float*)F.lds;
    for (int i = F.tid; i < 2048; i += 512) { const int b = i >> 10, col = i & 1023;
        const float sh = mods[b * NMOD + (3 * set) * D + col], sc = mods[b * NMOD + (3 * set + 1) * D + col];
        AB[(b * 2 + 0) * 1024 + col] = P.norm_g[set * D + col] * (1.0f + sc); AB[(b * 2 + 1) * 1024 + col] = sh; }
    __syncthreads();
    LAS float* scr = (LAS float*)(F.lds + 16384 + F.wave * 8704);
    const int gw = widx * NWAVES + F.wave, NGW = nw * NWAVES;
    constexpr int I_1O = (FF / 64) * (D / 32), I_MO = (D / 64) * (D / 32), I_MI = (D / 64) * (DIN / 32), I_2I = (D / 64) * (2 * FF / 32);
    if (part == 0) {
        for (int it = gw; it < I_1O + I_MI; it += NGW) {
            int r = it;
            if (r < I_1O) { p0_transpose_nat(P.w1o, FF, D, (bf16*)(P.ws + WS_W1O), scr, r, F.lane); continue; } r -= I_1O;
            const int nblk = DIN / 32, kb = r / nblk, nb = r % nblk;
            p0_transpose_mod(P.wmi, D, DIN, (bf16*)(P.ws + WS_WMI), (size_t)DIN * D, 64 * kb, 32 * nb, 32 * nb, scr, AB, (float*)(P.ws + WS_BMI), DIN, F.lane);
        }
    } else if (part == 1) {
        for (int it = gw; it < I_2I + I_MO + I_1O; it += NGW) {
            if (it >= I_2I + I_MO) { p0_transpose_nat(P.w2o, FF, D, (bf16*)(P.ws + WS_W2O), scr, it - I_2I - I_MO, F.lane); continue; }
            if (it >= I_2I) { p0_transpose_nat(P.wmo, D, D, (bf16*)(P.ws + WS_WMO), scr, it - I_2I, F.lane); continue; }
            const int nblk = (2 * FF) / 32, kb = it / nblk, nb = it % nblk, n0 = 32 * nb;
            p0_transpose_mod(P.w2i, D, 2 * FF, (bf16*)(P.ws + WS_W2I), (size_t)2 * FF * D, 64 * kb, n0, glu_row(n0), scr, AB, (float*)(P.ws + WS_B2I), 2 * FF, F.lane); }
    } else {
        for (int it = gw; it < I_1O; it += NGW) p0_transpose_nat(P.w2o, FF, D, (bf16*)(P.ws + WS_W2O), scr, it, F.lane);
    }
    __syncthreads();
}

__device__ __forceinline__ void phase_p0b(Frame& F, const Ptrs& P) {
    const float* mods = (const float*)(P.ws + WS_MODS);
    LAS float* AB = (LAS float*)F.lds;
    for (int i = F.tid; i < 2048; i += 512) { const int b = i >> 10, col = i & 1023;
        const float sh = mods[b * NMOD + col], sc = mods[b * NMOD + D + col];
        AB[(b * 2 + 0) * 1024 + col] = P.norm_g[col] * (1.0f + sc); AB[(b * 2 + 1) * 1024 + col] = sh; }
    __syncthreads();
    const int gw = F.vcu * NWAVES + F.wave, NGW = F.G * NWAVES;
    bf16* dst = (bf16*)(P.ws + WS_H);
    for (int m = gw; m < M; m += NGW) {
        const int b = m >= T;
        const GAS f32x4* xr = (const GAS f32x4*)(P.x + (size_t)m * D) + F.lane;
        f32x4 v[4]; float s = 0.f;
#pragma unroll
        for (int j = 0; j < 4; ++j) { v[j] = __builtin_nontemporal_load(xr + 64 * j); s += (v[j].x * v[j].x + v[j].y * v[j].y) + (v[j].z * v[j].z + v[j].w * v[j].w); }
        const float r = 1.0f / sqrtf(wave_sum(s) * (1.f / D) + EPS);
        GAS unsigned long long* o8 = (GAS unsigned long long*)(dst + (size_t)m * D) + F.lane;
#pragma unroll
        for (int j = 0; j < 4; ++j) { const f32x4 a = *(const LAS f32x4*)(AB + (b * 2 + 0) * 1024 + 256 * j + 4 * F.lane), sh = *(const LAS f32x4*)(AB + (b * 2 + 1) * 1024 + 256 * j + 4 * F.lane);
            const f32x4 o = v[j] * r * a + sh;
            o8[64 * j] = (unsigned long long)pk2(o.x, o.y) | ((unsigned long long)pk2(o.z, o.w) << 32); }
    }
    __syncthreads();
}

typedef float f32x16 __attribute__((ext_vector_type(16)));
typedef short v4i16_t __attribute__((ext_vector_type(4)));
typedef float f32x2_t __attribute__((ext_vector_type(2))); typedef __bf16 bf16x2_t __attribute__((ext_vector_type(2)));
__device__ __forceinline__ unsigned cvtpk_s(float lo, float hi) { f32x2_t v = {lo, hi}; bf16x2_t b = __builtin_convertvector(v, bf16x2_t); return __builtin_bit_cast(unsigned, b); }
__device__ __forceinline__ v4i16_t ds_tr16(LAS unsigned char* p) { return __builtin_amdgcn_ds_read_tr16_b64_v4i16((LAS v4i16_t*)p); }
__device__ __forceinline__ int crow16(int r, int hi) { return (r & 3) + 8 * (r >> 2) + 4 * hi; }
constexpr int AT_K = 0, AT_V = 49152, AT_T = 98304, AT_RK = 106496, AT_STG = 108544;

__device__ __forceinline__ void attn_phase(Frame& F, const Ptrs& P, const int xslot) {
    const bf16* Z = (const bf16*)(P.ws + WS_ZH); bf16* MIX = (bf16*)(P.ws + WS_MIX);
    LAS unsigned char* Kimg = F.lds + AT_K; LAS unsigned char* Vimg = F.lds + AT_V; LAS float* Tt = (LAS float*)(F.lds + AT_T); LAS float* rkT = (LAS float*)(F.lds + AT_RK);
    const int lane = F.lane, wave = F.wave, r32 = lane & 31, hi = lane >> 5, g = wave >> 1, qh = wave & 1;
    const float LOG2E = 1.4426950408889634f;
    const float shift = *(const float*)(P.ws + WS_LB + 8192);
    for (int item0 = F.vcu; item0 < 256; item0 += F.G) {
        int item = item0; if (xslot >= 0) { const int blk = 16 * (xslot >> 5) + ((xslot & 31) >> 1); item = (blk >> 6) * 128 + (xslot & 1) * 64 + (blk & 63); }
        const int b = item >> 7, kv = (item >> 6) & 1, n = item & 63, hq = 4 * kv + g;
        const int blk_lo = n == 0 ? 1 : 0, blk_hi = n == 63 ? 1 : 2;
        const long zrow0 = (long)b * T + 128 * (n - 1);
        for (int piece = wave; piece < 48; piece += 8) {
            const int blk = piece >> 4; if (blk < blk_lo || blk > blk_hi) continue;
            const int rr = lane >> 3, row = piece * 8 + rr, cK = (lane & 7) ^ rr, cV = (lane & 7) ^ (((rr >> 1) & 1) << 2);
            const bf16* rp = Z + (size_t)(zrow0 + row) * DIN;
            __builtin_amdgcn_global_load_lds((const unsigned*)(rp + ZC_AK + kv * 64 + cK * 8), (LAS unsigned*)(Kimg + piece * 1024), 16, 0, 0);
            __builtin_amdgcn_global_load_lds((const unsigned*)(rp + ZC_AV + kv * 64 + cV * 8), (LAS unsigned*)(Vimg + piece * 1024), 16, 0, 0);
        }
        bf16x8 qf[2][4];
        {
            float fac[4][8];
#pragma unroll
            for (int ks = 0; ks < 4; ++ks)
#pragma unroll
                for (int j = 0; j < 8; ++j) { const int d = 16 * ks + 8 * hi + j; fac[ks][j] = 0.125f * LOG2E * P.qkg[d] * P.qkg[64 + d]; }
#pragma unroll
            for (int sb = 0; sb < 2; ++sb) {
                const size_t m = (size_t)b * T + 128 * n + 64 * qh + 32 * sb + r32;
                const bf16* qp = Z + m * DIN + ZC_AQ + hq * 64 + 8 * hi;
                v4u raw[4]; float ss = 0.f;
#pragma unroll
                for (int ks = 0; ks < 4; ++ks) raw[ks] = *(const v4u*)(qp + 16 * ks);
#pragma unroll
                for (int ks = 0; ks < 4; ++ks) { const v4u w = raw[ks]; const float a0 = bflo(w.x), a1 = bfhi(w.x), a2 = bflo(w.y), a3 = bfhi(w.y), a4 = bflo(w.z), a5 = bfhi(w.z), a6 = bflo(w.w), a7 = bfhi(w.w);
                    ss += (a0 * a0 + a1 * a1) + (a2 * a2 + a3 * a3) + (a4 * a4 + a5 * a5) + (a6 * a6 + a7 * a7); }
                ss += __shfl_xor(ss, 32);
                const float rq = 1.0f / sqrtf(ss * (1.f / 64.f) + EPS);
#pragma unroll
                for (int ks = 0; ks < 4; ++ks) { const v4u w = raw[ks]; v4u o;
                    o.x = cvtpk_s(bflo(w.x) * rq * fac[ks][0], bfhi(w.x) * rq * fac[ks][1]); o.y = cvtpk_s(bflo(w.y) * rq * fac[ks][2], bfhi(w.y) * rq * fac[ks][3]);
                    o.z = cvtpk_s(bflo(w.z) * rq * fac[ks][4], bfhi(w.z) * rq * fac[ks][5]); o.w = cvtpk_s(bflo(w.w) * rq * fac[ks][6], bfhi(w.w) * rq * fac[ks][7]);
                    qf[sb][ks] = __builtin_bit_cast(bf16x8, o); }
            }
        }
        for (int idx = F.tid; idx < 4 * 512; idx += 512) { const int gg = idx >> 9, rel = (idx & 511) - 255, ar = rel < 0 ? -rel : rel;
            Tt[idx] = (ar <= 128) ? (P.relb[t5_bucket(rel) * 8 + 4 * kv + gg] - shift) * LOG2E : -30000.0f; }
        __syncthreads();
        if (F.tid < 384) { const int blk = F.tid >> 7; float rk = 0.f;
            if (blk >= blk_lo && blk <= blk_hi) { float ss = 0.f;
#pragma unroll
                for (int c = 0; c < 8; ++c) { const v4u w = *(const LAS v4u*)(Kimg + F.tid * 128 + c * 16);
                    const float a0 = bflo(w.x), a1 = bfhi(w.x), a2 = bflo(w.y), a3 = bfhi(w.y), a4 = bflo(w.z), a5 = bfhi(w.z), a6 = bflo(w.w), a7 = bfhi(w.w);
                    ss += (a0 * a0 + a1 * a1) + (a2 * a2 + a3 * a3) + (a4 * a4 + a5 * a5) + (a6 * a6 + a7 * a7); }
                rk = 1.0f / sqrtf(ss * (1.f / 64.f) + EPS); }
            rkT[F.tid] = rk; }
        __syncthreads();
        f32x16 O[2][2]; float lsum[2] = {0.f, 0.f};
#pragma unroll
        for (int sb = 0; sb < 2; ++sb)
#pragma unroll
            for (int db = 0; db < 2; ++db)
#pragma unroll
                for (int r = 0; r < 16; ++r) O[sb][db][r] = 0.f;
        int kt_lo = qh ? 2 : 0, kt_hi = qh ? 11 : 9;
        if (kt_lo < 4 * blk_lo) kt_lo = 4 * blk_lo;
        if (kt_hi > 4 * blk_hi + 3) kt_hi = 4 * blk_hi + 3;
        const int i16 = lane & 15, tq = i16 >> 2, tp = i16 & 3, tblk = (lane >> 4) & 1;
        for (int kt = kt_lo; kt <= kt_hi; ++kt) {
            const int key = 32 * kt + r32;
            bf16x8 kf[4];
#pragma unroll
            for (int ks = 0; ks < 4; ++ks) kf[ks] = *(const LAS bf16x8*)(Kimg + key * 128 + (((2 * ks + hi) ^ (key & 7)) << 4));
            f32x4 rkv[4];
#pragma unroll
            for (int g4 = 0; g4 < 4; ++g4) rkv[g4] = *(const LAS f32x4*)(rkT + 32 * kt + 8 * g4 + 4 * hi);
            bf16x8 vf[2][2];
#pragma unroll
            for (int db = 0; db < 2; ++db)
#pragma unroll
                for (int s = 0; s < 2; ++s) { const int k0 = 32 * kt + 16 * s + 4 * hi + tq, dbyte = (32 * db + 16 * tblk + 4 * tp) * 2;
                    const v4i16_t lo = ds_tr16(Vimg + k0 * 128 + (dbyte ^ (((k0 >> 1) & 1) << 6))), hh = ds_tr16(Vimg + (k0 + 8) * 128 + (dbyte ^ ((((k0 + 8) >> 1) & 1) << 6)));
                    vf[db][s] = (bf16x8){lo[0], lo[1], lo[2], lo[3], hh[0], hh[1], hh[2], hh[3]}; }
#pragma unroll
            for (int sb = 0; sb < 2; ++sb) {
                f32x16 S;
#pragma unroll
                for (int r = 0; r < 16; ++r) S[r] = 0.f;
#pragma unroll
                for (int ks = 0; ks < 4; ++ks) S = __builtin_amdgcn_mfma_f32_32x32x16_bf16(kf[ks], qf[sb][ks], S, 0, 0, 0);
                const LAS float* tb = Tt + g * 512 + (127 + 32 * kt - (64 * qh + 32 * sb + r32));
                float acc = 0.f;
#pragma unroll
                for (int r = 0; r < 16; ++r) { const float x = S[r] * rkv[r >> 2][r & 3] + tb[crow16(r, hi)]; S[r] = __builtin_amdgcn_exp2f(x); acc += S[r]; }
                lsum[sb] += acc;
                bf16x8 pf[2];
#pragma unroll
                for (int s = 0; s < 2; ++s) { v4u w; w.x = cvtpk_s(S[8 * s + 0], S[8 * s + 1]); w.y = cvtpk_s(S[8 * s + 2], S[8 * s + 3]); w.z = cvtpk_s(S[8 * s + 4], S[8 * s + 5]); w.w = cvtpk_s(S[8 * s + 6], S[8 * s + 7]);
                    pf[s] = __builtin_bit_cast(bf16x8, w); }
#pragma unroll
                for (int db = 0; db < 2; ++db)
#pragma unroll
                    for (int s = 0; s < 2; ++s) O[sb][db] = __builtin_amdgcn_mfma_f32_32x32x16_bf16(vf[db][s], pf[s], O[sb][db], 0, 0, 0);
            }
        }
        const float sinkp = __builtin_amdgcn_exp2f((P.sink[hq] - shift) * LOG2E);
        LAS unsigned char* stg = F.lds + AT_STG + wave * 2048;
#pragma unroll
        for (int sb = 0; sb < 2; ++sb) {
            const float l = lsum[sb] + __shfl_xor(lsum[sb], 32) + sinkp, il = 1.0f / l;
            const size_t m0 = (size_t)b * T + 128 * n + 64 * qh + 32 * sb;
#pragma unroll
            for (int db = 0; db < 2; ++db) {
#pragma unroll
                for (int g4 = 0; g4 < 4; ++g4) { const unsigned lo = cvtpk_s(O[sb][db][4 * g4] * il, O[sb][db][4 * g4 + 1] * il), hh = cvtpk_s(O[sb][db][4 * g4 + 2] * il, O[sb][db][4 * g4 + 3] * il);
                    *(LAS unsigned long long*)(stg + r32 * 64 + ((g4 ^ ((r32 >> 1) & 3)) << 4) + 8 * hi) = (unsigned long long)lo | ((unsigned long long)hh << 32); }
                asm volatile("s_waitcnt lgkmcnt(0)" ::: "memory");
#pragma unroll
                for (int k2 = 0; k2 < 2; ++k2) { const int row = 16 * k2 + (lane >> 2), ch = lane & 3;
                    const v4u w = *(const LAS v4u*)(stg + row * 64 + ((ch ^ ((row >> 1) & 3)) << 4));
                    *(v4u*)(MIX + (m0 + row) * D + 512 + hq * 64 + 32 * db + 8 * ch) = w; }
                asm volatile("s_waitcnt lgkmcnt(0)" ::: "memory");
            }
        }
        __syncthreads();
    }
}

typedef float f32x2v __attribute__((ext_vector_type(2)));
constexpr int HG_Q = 0, HG_G = 16384, HG_V = 32768, HG_QT = 65536, HG_KT = 81920, HG_KD = 98304, HG_A = 114688;
#define MFMA16(a, b, c) __builtin_amdgcn_mfma_f32_16x16x32_bf16((a), (b), (c), 0, 0, 0)
__device__ __forceinline__ bf16x8 tr_pair(LAS unsigned char* lo, LAS unsigned char* hh) { const v4i16_t a = ds_tr16(lo), b = ds_tr16(hh); return (bf16x8){a[0], a[1], a[2], a[3], b[0], b[1], b[2], b[3]}; }
__device__ __forceinline__ bf16x8 pack8(f32x4 a, f32x4 b) { v4u w; w.x = cvtpk_s(a[0], a[1]); w.y = cvtpk_s(a[2], a[3]); w.z = cvtpk_s(b[0], b[1]); w.w = cvtpk_s(b[2], b[3]); return __builtin_bit_cast(bf16x8, w); }

__device__ __forceinline__ void glds16(const void* gsrc, unsigned lds_dst) { unsigned keep;
    asm volatile("s_mov_b32 %0, m0\n\ts_mov_b32 m0, %2\n\ts_nop 0\n\tglobal_load_lds_dwordx4 %1, off\n\ts_mov_b32 m0, %0" : "=&s"(keep) : "v"(gsrc), "s"(lds_dst) : "memory"); }
#define HG_SW(r) ((((r) & 15) ^ ((((r) >> 4) & 3) << 1)) << 4)
#define HG_BAR_L() do { asm volatile("s_waitcnt lgkmcnt(0)" ::: "memory"); __builtin_amdgcn_s_barrier(); asm volatile("" ::: "memory"); } while (0)
#define HG_BAR_VL() do { asm volatile("s_waitcnt vmcnt(0) lgkmcnt(0)" ::: "memory"); __builtin_amdgcn_s_barrier(); asm volatile("" ::: "memory"); } while (0)
#define HG_BAR_V16L() do { asm volatile("s_waitcnt vmcnt(16) lgkmcnt(0)" ::: "memory"); __builtin_amdgcn_s_barrier(); asm volatile("" ::: "memory"); } while (0)
constexpr int HP_Q = 0, HP_G = 16384, HP_V = 32768, HP_IMG = 65536  , HP_A = 131072, HP_TOT = 139264  , HP_TAB = 141312  ;
static_assert(HP_TAB + 2 * 1536 <= RING_BYTES, "pass-1 LDS map");
__device__ __forceinline__ void hgrn_pass1(Frame& F, const Ptrs& P, const int xslot) {
    bf16* Z = (bf16*)(P.ws + WS_ZH); bf16* OL = (bf16*)P.out; float* SLOC = (float*)(P.ws + WS_SLOC); float* DSEG = (float*)(P.ws + WS_DSEG);
    LAS unsigned char* L = F.lds;
    const unsigned lds0 = (unsigned)(uintptr_t)(unsigned char*)F.lds;
    const int lane = F.lane, wave = F.wave;
    const bool isM = wave < 4; const int mw = wave & 3;
    const float LOG2E = 1.4426950408889634f;
    for (int item0 = F.vcu; item0 < 256; item0 += F.G) {
        int item = item0; if (xslot >= 0) { const int x_ = xslot >> 5, r_ = xslot & 31, d_ = (r_ >> 2) & 1, tb_ = 4 * (x_ & 3) + (r_ >> 3); item = ((((x_ >> 2) * 4 + (r_ & 3)) * 2 + d_) << 4) + (d_ ? 15 - tb_ : tb_); }
        const int chain = item >> 4, p = item & 15, dir = chain & 1, h = (chain >> 1) & 3, b = chain >> 3;
        const int qcol = ZC_Q + h * 128, gcol = (dir ? ZC_GB : ZC_GF) + h * 128, vcol = ZC_V + h * 128;
        const int tok0 = dir ? (512 * (15 - p) + 511) : 512 * p, tstep = dir ? -1 : 1;
        const size_t rowb = (size_t)b * T;
        if (!isM) {
            float goff0 = 0.f, goff1 = 0.f;
            f32x2v qv[16], gl[16];
#define HP_DMA_QG(c) do { _Pragma("unroll") for (int k_ = 0; k_ < 8; ++k_) { const int tile = k_ >> 2, pp = 4 * mw + (k_ & 3), row = 4 * pp + (lane >> 4); \
                const int csrc = (lane & 15) ^ (HG_SW(row) >> 4); \
                const bf16* src = Z + (rowb + tok0 + tstep * (64 * (c) + row)) * DIN + (tile ? gcol : qcol) + 8 * csrc; \
                glds16(src, (unsigned)__builtin_amdgcn_readfirstlane(lds0 + (tile ? HP_G : HP_Q) + pp * 1024)); } } while (0)
#define HP_DMA_V(c) do { _Pragma("unroll") for (int k_ = 0; k_ < 4; ++k_) { const int pp = 4 * mw + k_, row = 4 * pp + (lane >> 4); \
                const int csrc = (lane & 15) ^ (HG_SW(row) >> 4); \
                const bf16* src = Z + (rowb + tok0 + tstep * (64 * (c) + row)) * DIN + vcol + 8 * csrc; \
                glds16(src, (unsigned)__builtin_amdgcn_readfirstlane(lds0 + HP_V + ((c) & 1) * 16384 + pp * 1024)); } } while (0)
#define HP_EW1(cc) do { f32x2v run = {0.f, 0.f}; \
                _Pragma("unroll") for (int u = 0; u < 16; ++u) { const int r = 16 * mw + u, off = r * 256 + ((lane * 4) ^ HG_SW(r)); const unsigned wq = *(const LAS unsigned*)(L + HP_Q + off), wg = *(const LAS unsigned*)(L + HP_G + off); \
                    qv[u] = (f32x2v){bflo(wq), bfhi(wq)}; run = run + (f32x2v){bflo(wg), bfhi(wg)} * LOG2E; gl[u] = run; } \
                *(LAS f32x2v*)(L + HP_TOT + (mw * 128 + 2 * lane) * 4) = run; } while (0)
#define HP_EW2(cc) do { f32x2v base = {0.f, 0.f}, gmid = {0.f, 0.f}, glast = {0.f, 0.f}; \
                _Pragma("unroll") for (int w2 = 0; w2 < 4; ++w2) { const f32x2v tv = *(const LAS f32x2v*)(L + HP_TOT + (w2 * 128 + 2 * lane) * 4); \
                    if (w2 < mw) base = base + tv; if (w2 < 2) gmid = gmid + tv; glast = glast + tv; } \
                const f32x2v c2_ = gmid + (f32x2v){goff0, goff1}; const f32x2v sgv = {__builtin_amdgcn_exp2f(c2_.x), __builtin_amdgcn_exp2f(c2_.y)}; \
                const f32x2v bmg = base - gmid; LAS unsigned char* img = L + HP_IMG + ((cc) & 1) * 32768; \
                _Pragma("unroll") for (int u = 0; u < 16; ++u) { const int r = 16 * mw + u; \
                    f32x2v x = bmg + gl[u]; x.x = fminf(fmaxf(x.x, -115.f), 115.f); x.y = fminf(fmaxf(x.y, -115.f), 115.f); \
                    const f32x2v E = {__builtin_amdgcn_exp2f(x.x), __builtin_amdgcn_exp2f(x.y)}, I = {__builtin_amdgcn_rcpf(E.x), __builtin_amdgcn_rcpf(E.y)}; \
                    const f32x2v g2 = u ? gl[u] - gl[u - 1] : gl[u]; \
                    const f32x2v k = 1.0f - (f32x2v){__builtin_amdgcn_exp2f(g2.x), __builtin_amdgcn_exp2f(g2.y)}; \
                    const f32x2v Q = qv[u] * E, K = k * I, QS = Q * sgv; \
                    const int off = r * 256 + ((lane * 4) ^ HG_SW(r)); \
                    *(LAS unsigned*)(img + off) = cvtpk_s(Q.x, Q.y); *(LAS unsigned*)(img + 16384 + off) = cvtpk_s(K.x, K.y); \
                    *(unsigned*)(Z + (rowb + tok0 + tstep * (64 * (cc) + r)) * DIN + gcol + 2 * lane) = cvtpk_s(QS.x, QS.y); } \
                if (mw == 0) { LAS unsigned char* tb = L + HP_TAB + ((cc) & 1) * 1536; const f32x2v dlt = glast - gmid; \
                    *(LAS f32x2v*)(tb + 8 * lane) = (f32x2v){__builtin_amdgcn_exp2f(glast.x), __builtin_amdgcn_exp2f(glast.y)}; \
                    *(LAS f32x2v*)(tb + 512 + 8 * lane) = (f32x2v){__builtin_amdgcn_exp2f(gmid.x), __builtin_amdgcn_exp2f(gmid.y)}; \
                    *(LAS f32x2v*)(tb + 1024 + 8 * lane) = (f32x2v){__builtin_amdgcn_exp2f(dlt.x), __builtin_amdgcn_exp2f(dlt.y)}; } \
                goff0 += glast.x; goff1 += glast.y; } while (0)
            HP_DMA_QG(0); HP_DMA_V(0);
            HG_BAR_VL();
            HP_EW1(0); HP_DMA_QG(1); HP_DMA_V(1);
            HG_BAR_L();
            HP_EW2(0);
            HG_BAR_V16L();
            for (int c = 0; c < 8; ++c) {
                if (c + 1 < 8) { HP_EW1(c + 1); if (c + 2 < 8) HP_DMA_QG(c + 2); }
                HG_BAR_L();
                if (c + 2 < 8) HP_DMA_V(c + 2);
                if (c + 1 < 8) HP_EW2(c + 1);
                HG_BAR_V16L();
            }
            if (mw == 0) *(f32x2v*)(DSEG + item * 128 + 2 * lane) = (f32x2v){__builtin_amdgcn_exp2f(goff0), __builtin_amdgcn_exp2f(goff1)};
#undef HP_DMA_QG
#undef HP_DMA_V
#undef HP_EW1
#undef HP_EW2
        } else {
            f32x4 S[8][2];
#pragma unroll
            for (int db = 0; db < 8; ++db) { S[db][0] = (f32x4){0.f, 0.f, 0.f, 0.f}; S[db][1] = (f32x4){0.f, 0.f, 0.f, 0.f}; }
            HG_BAR_VL(); HG_BAR_L(); HG_BAR_VL();
            for (int c = 0; c < 8; ++c) {
                int l15 = lane & 15, g = lane >> 4; asm volatile("" : "+v"(l15), "+v"(g));
                const int tq = l15 >> 2, tp = l15 & 3;
                LAS unsigned char* QT = L + HP_IMG + (c & 1) * 32768; LAS unsigned char* KT = QT + 16384; LAS unsigned char* Vc = L + HP_V + (c & 1) * 16384; LAS unsigned char* tb = L + HP_TAB + (c & 1) * 1536;
                { const int rowq = 16 * mw + l15; bf16x8 qf[4], kf[4][4];
#pragma unroll
                  for (int kk = 0; kk < 4; ++kk) { qf[kk] = *(const LAS bf16x8*)(QT + rowq * 256 + (((4 * kk + g) << 4) ^ HG_SW(rowq)));
#pragma unroll
                      for (int j = 0; j < 4; ++j) { const int rowk = 16 * j + l15; kf[j][kk] = *(const LAS bf16x8*)(KT + rowk * 256 + (((4 * kk + g) << 4) ^ HG_SW(rowk))); } }
                  __builtin_amdgcn_sched_barrier(0);
#pragma unroll
                  for (int j = 0; j < 4; ++j) { f32x4 C = {0.f, 0.f, 0.f, 0.f};
#pragma unroll
                      for (int kk = 0; kk < 4; ++kk) C = MFMA16(kf[j][kk], qf[kk], C);
                      const int s0 = 16 * j + 4 * g, t = rowq;
                      const unsigned lo = cvtpk_s(s0 + 0 <= t ? C[0] : 0.f, s0 + 1 <= t ? C[1] : 0.f), hh = cvtpk_s(s0 + 2 <= t ? C[2] : 0.f, s0 + 3 <= t ? C[3] : 0.f);
                      *(LAS unsigned long long*)(L + HP_A + t * 128 + (((2 * j + (g >> 1)) ^ (t & 7)) << 4) + 8 * (g & 1)) = (unsigned long long)lo | ((unsigned long long)hh << 32); } }
                f32x4 oT[4][2];
#pragma unroll
                for (int ti = 0; ti < 4; ++ti) { oT[ti][0] = (f32x4){0.f, 0.f, 0.f, 0.f}; oT[ti][1] = (f32x4){0.f, 0.f, 0.f, 0.f}; }
                { f32x4 m0[4], m1[4]; unsigned long long q0[4][4], q1[4][4];
#pragma unroll
                  for (int kk = 0; kk < 4; ++kk) { m0[kk] = *(const LAS f32x4*)(tb + 512 + (32 * kk + 4 * g) * 4); m1[kk] = *(const LAS f32x4*)(tb + 512 + (32 * kk + 16 + 4 * g) * 4);
#pragma unroll
                      for (int ti = 0; ti < 4; ++ti) { const int t = 16 * ti + l15, db0 = 64 * kk + 8 * g;
                          q0[kk][ti] = *(const LAS unsigned long long*)(QT + t * 256 + (db0 ^ HG_SW(t))); q1[kk][ti] = *(const LAS unsigned long long*)(QT + t * 256 + ((db0 + 32) ^ HG_SW(t))); } }
                  __builtin_amdgcn_sched_barrier(0);
#pragma unroll
                  for (int kk = 0; kk < 4; ++kk) {
                      const bf16x8 sf0 = pack8(S[2 * kk][0] * m0[kk], S[2 * kk + 1][0] * m1[kk]), sf1 = pack8(S[2 * kk][1] * m0[kk], S[2 * kk + 1][1] * m1[kk]);
#pragma unroll
                      for (int ti = 0; ti < 4; ++ti) { v4u w; w.x = (unsigned)q0[kk][ti]; w.y = (unsigned)(q0[kk][ti] >> 32); w.z = (unsigned)q1[kk][ti]; w.w = (unsigned)(q1[kk][ti] >> 32); const bf16x8 qb = __builtin_bit_cast(bf16x8, w);
                          oT[ti][0] = MFMA16(sf0, qb, oT[ti][0]); oT[ti][1] = MFMA16(sf1, qb, oT[ti][1]); } } }
                bf16x8 vf[2][2];
#pragma unroll
                for (int kk = 0; kk < 2; ++kk)
#pragma unroll
                    for (int es = 0; es < 2; ++es) { const int s = 32 * kk + 8 * g + tq, cb = 64 * mw + 32 * es + 8 * tp;
                        vf[kk][es] = tr_pair(Vc + s * 256 + (cb ^ HG_SW(s)), Vc + (s + 4) * 256 + (cb ^ HG_SW(s + 4))); }
#pragma unroll
                for (int dg = 0; dg < 2; ++dg) { f32x4 ta[4], tbv[4]; bf16x8 kd[4][2];
#pragma unroll
                    for (int d4 = 0; d4 < 4; ++d4) { const int db = 4 * dg + d4; ta[d4] = *(const LAS f32x4*)(tb + (16 * db + 4 * g) * 4); tbv[d4] = *(const LAS f32x4*)(tb + 1024 + (16 * db + 4 * g) * 4);
#pragma unroll
                        for (int kk = 0; kk < 2; ++kk) { const int s = 32 * kk + 8 * g + tq, cb = 32 * db + 8 * tp;
                            kd[d4][kk] = tr_pair(KT + s * 256 + (cb ^ HG_SW(s)), KT + (s + 4) * 256 + (cb ^ HG_SW(s + 4))); } }
                    __builtin_amdgcn_sched_barrier(0);
#pragma unroll
                    for (int d4 = 0; d4 < 4; ++d4) { const int db = 4 * dg + d4;
#pragma unroll
                        for (int es = 0; es < 2; ++es) { f32x4 kv = {0.f, 0.f, 0.f, 0.f}; kv = MFMA16(kd[d4][0], vf[0][es], kv); kv = MFMA16(kd[d4][1], vf[1][es], kv);
                            S[db][es] = S[db][es] * ta[d4] + kv * tbv[d4]; } } }
                HG_BAR_L();
#pragma unroll
                for (int ti = 0; ti < 4; ++ti)
#pragma unroll
                    for (int kk = 0; kk < 2; ++kk) { if (kk == 1 && ti < 2) continue; const int t = 16 * ti + l15;
                        const bf16x8 af = *(const LAS bf16x8*)(L + HP_A + t * 128 + (((4 * kk + g) ^ (t & 7)) << 4));
                        oT[ti][0] = MFMA16(vf[kk][0], af, oT[ti][0]); oT[ti][1] = MFMA16(vf[kk][1], af, oT[ti][1]); }
#pragma unroll
                for (int ti = 0; ti < 4; ++ti)
#pragma unroll
                    for (int es = 0; es < 2; ++es) { const int r = 16 * ti + l15;
                        const size_t tk = (size_t)dir * M + rowb + tok0 + tstep * (64 * c + r);
                        *(unsigned long long*)(OL + ((tk >> 4) * 4 + h) * 2048 + (8 * mw + 4 * es + g) * 64 + (tk & 15) * 4) =
                            (unsigned long long)cvtpk_s(oT[ti][es][0], oT[ti][es][1]) | ((unsigned long long)cvtpk_s(oT[ti][es][2], oT[ti][es][3]) << 32); }
                HG_BAR_L();
            }
            { const int l15 = lane & 15, g = lane >> 4;
#pragma unroll
              for (int db = 0; db < 8; ++db)
#pragma unroll
                  for (int es = 0; es < 2; ++es) { const f32x4 sv = S[db][es];
                      *(unsigned long long*)((bf16*)SLOC + (size_t)item * 16384 + (32 * mw + 16 * es + l15) * 128 + 16 * db + 4 * g) = (unsigned long long)cvtpk_s(sv[0], sv[1]) | ((unsigned long long)cvtpk_s(sv[2], sv[3]) << 32); } }
        }
        HG_BAR_VL();
    }
}

__device__ __forceinline__ void hgrn_pass2(Frame& F, const Ptrs& P) {
    const float* SLOC = (const float*)(P.ws + WS_SLOC); const float* DSEG = (const float*)(P.ws + WS_DSEG); bf16* SIN = (bf16*)(P.ws + WS_SIN);
    for (int gid = blockIdx.x * 512 + F.tid; gid < 16 * 8192; gid += F.G * 512) {
        const int chain = gid >> 13, flat = 2 * (gid & 8191), d = flat & 127;
        float s0 = 0.f, s1 = 0.f;
#pragma unroll
        for (int p = 0; p < 16; ++p) { const size_t item = (size_t)chain * 16 + p;
            *(unsigned*)(SIN + item * 16384 + flat) = cvtpk_s(s0, s1);
            const unsigned xw = *(const unsigned*)((const bf16*)SLOC + item * 16384 + flat); const f32x2v x = {bflo(xw), bfhi(xw)}, dd = *(const f32x2v*)(DSEG + item * 128 + d);
            s0 = dd.x * s0 + x.x; s1 = dd.y * s1 + x.y; }
    }
}

__device__ __forceinline__ void hgrn_pass3(Frame& F, const Ptrs& P, const int xslot) {
    const bf16* Z = (const bf16*)(P.ws + WS_ZH); const bf16* OL = (const bf16*)P.out; const bf16* SIN = (const bf16*)(P.ws + WS_SIN); bf16* MIX = (bf16*)(P.ws + WS_MIX);
    LAS unsigned char* L = F.lds;
    const int lane = F.lane, wave = F.wave, l15 = lane & 15, g = lane >> 4;
    for (int it0 = F.vcu; it0 < 256; it0 += F.G) {
        int it = it0; if (xslot >= 0) { const int panel = 8 * (xslot >> 5) + ((xslot & 31) >> 2); it = (panel >> 5) * 128 + (xslot & 3) * 32 + (panel & 31); }
        const int hf = it & 1, ns = (it >> 1) & 15, h = (it >> 5) & 3, b = it >> 7;
        const int itemf = ((b * 4 + h) * 2 + 0) * 16 + ns, itemb = ((b * 4 + h) * 2 + 1) * 16 + (15 - ns);
#pragma unroll
        for (int k_ = 0; k_ < 8; ++k_) { const int piece = wave + 8 * k_, dr = piece >> 5, pp = piece & 31, e = 4 * pp + (lane >> 4), cs = (lane & 15) ^ (e & 15);
            const bf16* src = SIN + (size_t)(dr ? itemb : itemf) * 16384 + e * 128 + 8 * cs;
            __builtin_amdgcn_global_load_lds((const unsigned*)src, (LAS unsigned*)(L + dr * 32768 + pp * 1024), 16, 0, 0); }
        const size_t tokw = (size_t)b * T + 512 * ns + 256 * hf + 32 * wave;
        LAS unsigned char* stg = L + 65536 + wave * 4096;
        __syncthreads();
#pragma unroll 1
        for (int tt = 0; tt < 2; ++tt) {
            const size_t tok = tokw + 16 * tt + l15;
            f32x4 acc[8];
#pragma unroll
            for (int et = 0; et < 8; ++et) acc[et] = (f32x4){0.f, 0.f, 0.f, 0.f};
#pragma unroll 1
            for (int dr = 0; dr < 2; ++dr) {
                const bf16* qp = Z + tok * DIN + (dr ? ZC_GB : ZC_GF) + h * 128 + 8 * g;
                bf16x8 qf[4];
#pragma unroll
                for (int kk = 0; kk < 4; ++kk) qf[kk] = *(const bf16x8*)(qp + 32 * kk);
                LAS unsigned char* sb = L + dr * 32768 + l15 * 256;
#pragma unroll
                for (int kk = 0; kk < 4; ++kk) { LAS unsigned char* sk = sb + (((4 * kk + g) ^ l15) << 4);
                    bf16x8 sf[8];
#pragma unroll
                    for (int et = 0; et < 8; ++et) sf[et] = *(const LAS bf16x8*)(sk + et * 4096);
#pragma unroll
                    for (int et = 0; et < 8; ++et) acc[et] = MFMA16(sf[et], qf[kk], acc[et]); }
            }
            const bf16* olf = OL + ((tok >> 4) * 4 + h) * 2048 + g * 64 + l15 * 4; const bf16* olb = olf + (size_t)M * 512;
            float ss = 0.f;
#pragma unroll
            for (int et = 0; et < 8; ++et) {
                const unsigned long long a = *(const unsigned long long*)(olf + 256 * et), c2 = *(const unsigned long long*)(olb + 256 * et);
                f32x4 o = acc[et];
                o[0] += bflo((unsigned)a) + bflo((unsigned)c2); o[1] += bfhi((unsigned)a) + bfhi((unsigned)c2);
                o[2] += bflo((unsigned)(a >> 32)) + bflo((unsigned)(c2 >> 32)); o[3] += bfhi((unsigned)(a >> 32)) + bfhi((unsigned)(c2 >> 32));
                acc[et] = o; ss += (o[0] * o[0] + o[1] * o[1]) + (o[2] * o[2] + o[3] * o[3]); }
            ss += __shfl_xor(ss, 16); ss += __shfl_xor(ss, 32);
            const float r = 1.0f / sqrtf(ss * (1.f / 128.f) + EPS);
            const bf16* gtp = Z + tok * DIN + ZC_GATE + h * 128 + 4 * g; const float* ngp = P.hng + h * 128 + 4 * g;
#pragma unroll
            for (int et = 0; et < 8; ++et) {
                const unsigned long long gt = *(const unsigned long long*)(gtp + 16 * et); const f32x4 ng = *(const f32x4*)(ngp + 16 * et); const f32x4 o = acc[et];
                const unsigned lo = cvtpk_s(o[0] * r * ng[0] * bflo((unsigned)gt), o[1] * r * ng[1] * bfhi((unsigned)gt)), hh = cvtpk_s(o[2] * r * ng[2] * bflo((unsigned)(gt >> 32)), o[3] * r * ng[3] * bfhi((unsigned)(gt >> 32)));
                *(LAS unsigned long long*)(stg + l15 * 256 + (((2 * et + (g >> 1)) ^ l15) << 4) + 8 * (g & 1)) = (unsigned long long)lo | ((unsigned long long)hh << 32); }
            asm volatile("s_waitcnt lgkmcnt(0)" ::: "memory");
#pragma unroll
            for (int k4 = 0; k4 < 4; ++k4) { const int row = 4 * k4 + (lane >> 4), ch = lane & 15;
                const v4u w = *(const LAS v4u*)(stg + row * 256 + ((ch ^ row) << 4));
                *(v4u*)(MIX + (tokw + 16 * tt + row) * D + h * 128 + 8 * ch) = w; }
            asm volatile("s_waitcnt lgkmcnt(0)" ::: "memory");
        }
        __syncthreads();
    }
}

__device__ __forceinline__ void refresh_frame(Frame& F) { int t = threadIdx.x; asm volatile("" : "+v"(t)); F.tid = t; F.lane = t & 63; }
struct Args { Ptrs p; int ph_lo, ph_hi, li, pad; };
__global__ void __launch_bounds__(NWAVES * 64, 2) mk_fwd(Args args) {
    extern __shared__ __attribute__((aligned(16))) unsigned char lds[];
    Frame F;
    F.lds = (LAS unsigned char*)lds;
    F.MISC = (volatile LAS unsigned*)(F.lds + MISC_OFF);
    F.tid = threadIdx.x; F.lane = F.tid & 63; F.wave = __builtin_amdgcn_readfirstlane(F.tid >> 6);
    F.G = gridDim.x; { const int bx = blockIdx.x; F.vcu = (F.G % 8 == 0) ? (bx % 8) * (F.G / 8) + bx / 8 : bx; }
    const Ptrs& P = args.p;
    F.ctl = (gu32*)(P.ws + WS_CTL);
    for (int u = F.tid; u < (LDS_BYTES - LDSCTL_OFF) / 4; u += NWAVES * 64) ((LAS unsigned*)(F.lds + LDSCTL_OFF))[u] = 0u;
    __syncthreads();
    XcdBarrier bar; bar.bar = (unsigned*)(F.ctl + CW_BAR); bar.x = 0; bar.st = nullptr;
    if (N_LAUNCHES != PER_PHASE) bar = xcd_barrier_post((unsigned*)(F.ctl + CW_BAR), F.MISC + 8);
#define GRID_BAR() do { if (N_LAUNCHES != PER_PHASE) xcd_barrier(bar); } while (0)
#define LOCAL_OK() (N_LAUNCHES != PER_PHASE && F.G == 256 && F.MISC[8 + 5] == 1u)
#define XSLOT() (LOCAL_OK() ? (int)(bar.x * 32u + F.MISC[8 + 4]) : -1)
#define GEMM_C() (LOCAL_OK() ? (int)(F.MISC[8 + 4] * 8u + bar.x) : (int)blockIdx.x)
#define LOCAL_BAR() do { if (N_LAUNCHES != PER_PHASE) { if (LOCAL_OK()) xcd_local_barrier(bar); else xcd_barrier(bar); } } while (0)
    const int lo = args.ph_lo, hi = args.ph_hi;
#define IN(k) (refresh_frame(F), lo <= (k) && (k) < hi)
#define BOTH(k) (IN(k) && IN((k) + 1))
    bf16* const Hb = (bf16*)(P.ws + WS_H); bf16* const ZH = (bf16*)(P.ws + WS_ZH); bf16* const MIXb = (bf16*)(P.ws + WS_MIX);
    const float* const mods = (const float*)(P.ws + WS_MODS);

    bf16* const Xb = (bf16*)(P.ws + WS_X);
    float* const SS1 = (float*)(P.ws + WS_SS1); float* const SS2 = (float*)(P.ws + WS_SS2);
    if (IN(0)) { phase_p0a(F, P); if (BOTH(0) && N_LAUNCHES != PER_PHASE) xcd_barrier_arrive(bar); phase_p0a_weights(F, P, 0, 0); if (BOTH(0) && N_LAUNCHES != PER_PHASE) xcd_barrier_wait(bar); }
    if (IN(1)) { phase_p0b(F, P); if (BOTH(1) && N_LAUNCHES != PER_PHASE) { xcd_barrier_arrive(bar); adaln_gemv<16, 1>(F, P); phase_p0a_weights(F, P, 1, 96); xcd_barrier_wait(bar); } else { adaln_gemv<16, 1>(F, P); phase_p0a_weights(F, P, 1, 96); } }
    if (IN(2)) { const int gc = GEMM_C();
        pg8::Gemm g{Hb, (const bf16*)(P.ws + WS_W1I), M, 2 * FF, D, 0}; pg8::StaticOrder S; S.init(M, 2 * FF, F.G, gc, WG_IN);
        pg8::EpiSwiGLU<false> E{ZH, FF, nullptr, 0, {}};
        pg8::gemm_phase<pg8::EpiSwiGLU<false>, pg8::StaticOrder, PG8_ALIGN, PG8_SP2>(F.lds + RING_OFF, g, S, E);
        { const int nfull = (M / 256) * (2 * FF / 256) % F.G;
          if (nfull == 0) deferred_weights(F, P, 0, gc, F.G); else if (gc >= nfull) deferred_weights(F, P, 0, gc - nfull, F.G - nfull); }
        if (BOTH(2) && N_LAUNCHES != PER_PHASE) { xcd_barrier_arrive(bar); adaln_gemv<4, 2>(F, P); xcd_barrier_wait(bar); } else adaln_gemv<4, 2>(F, P);
    }
    if (IN(3)) { const int gc = GEMM_C();
        pg8::Gemm g{ZH, (const bf16*)(P.ws + WS_W1O), M, D, FF, 0}; pg8::StaticOrder S; S.init(M, D, F.G, gc, WG_OUT);
        pg8::EpiResid<0> E{P.x, nullptr, Xb, nullptr, mods + 2 * D, NMOD, 0.5f, SS1};
        pg8::gemm_phase<pg8::EpiResid<0>, pg8::StaticOrder, PG8_ALIGN, PG8_SP2>(F.lds + RING_OFF, g, S, E);
        if (BOTH(3)) LOCAL_BAR();
    }
    if (IN(4)) { const int gc = GEMM_C();
        pg8::Gemm g{Xb, (const bf16*)(P.ws + WS_WMI), M, DIN, D, (size_t)DIN * D * 2}; pg8::StaticOrder S; S.init(M, DIN, F.G, gc, WG_IN, (28 << 8) | (20 << 16) | (8 << 24));
        pg8::EpiMixIn E{ZH, (LAS float*)(F.lds + pg8::EPT_OFF), 0, {}};
        { const float* lb = (const float*)(P.ws + WS_LB); const float* bmi = (const float*)(P.ws + WS_BMI); const int h = F.tid >> 8, e = F.tid & 255;
#pragma unroll
          for (int k = 0; k < 6; ++k) { const int p = 2 * k + h, i = p / 3, a = p % 3; pg8::Unit u; float v = 1.0f;
              if (S.next(i, u)) { if (a == 0) v = SS1[u.pm * 256 + e]; else if (a == 1) v = bmi[(u.pm >= 32 ? DIN : 0) + u.pn * 256 + e]; else if (u.pn >= 2 && u.pn < 6) v = lb[u.pn * 256 + e - 512]; }
              E.tv.v[k] = v; }
          int nu = 0; { pg8::Unit u; while (nu < 4 && S.next(nu, u)) ++nu; } E.npairs = 3 * nu; }
        pg8::gemm_phase<pg8::EpiMixIn, pg8::StaticOrder, PG8_ALIGN, PG8_SP2>(F.lds + RING_OFF, g, S, E);
        { const int nfull = (M / 256) * (DIN / 256) % F.G, cl = S.slot((M / 256) * (DIN / 256) / F.G);
          if (nfull == 0) deferred_weights(F, P, 1, gc, F.G); else if (cl >= nfull) deferred_weights(F, P, 1, cl - nfull, F.G - nfull); }
        if (BOTH(4)) LOCAL_BAR();
    }
    if (IN(5)) { hgrn_pass1(F, P, XSLOT()); if (BOTH(5)) GRID_BAR(); }
    if (IN(6)) { hgrn_pass2(F, P); if (BOTH(6) && N_LAUNCHES != PER_PHASE) xcd_barrier_arrive(bar); attn_phase(F, P, XSLOT()); if (BOTH(6) && N_LAUNCHES != PER_PHASE) xcd_barrier_wait(bar); }
    if (IN(7)) { hgrn_pass3(F, P, XSLOT()); if (BOTH(7)) LOCAL_BAR(); }
    if (IN(8)) { const int gc = GEMM_C();
        pg8::Gemm g{MIXb, (const bf16*)(P.ws + WS_WMO), M, D, D, 0}; pg8::StaticOrder S; S.init(M, D, F.G, gc, WG_OUT);
        pg8::EpiResid<1> E{nullptr, Xb, Xb, nullptr, mods + 5 * D, NMOD, 1.0f, SS2};
        pg8::gemm_phase<pg8::EpiResid<1>, pg8::StaticOrder, PG8_ALIGN, PG8_SP2>(F.lds + RING_OFF, g, S, E);
        if (BOTH(8)) LOCAL_BAR();
    }
    if (IN(9)) { const int gc = GEMM_C();
        pg8::Gemm g{Xb, (const bf16*)(P.ws + WS_W2I), M, 2 * FF, D, (size_t)2 * FF * D * 2}; pg8::StaticOrder S; S.init(M, 2 * FF, F.G, gc, WG_IN);
        pg8::EpiSwiGLU<true> E{ZH, FF, (LAS float*)(F.lds + pg8::EPT_OFF), 0, {}};
        { const float* b2i = (const float*)(P.ws + WS_B2I); const int h = F.tid >> 8, e = F.tid & 255;
#pragma unroll
          for (int k = 0; k < 6; ++k) { pg8::Unit u; float v = 1.0f;
              if (S.next(k, u)) v = h == 0 ? SS2[u.pm * 256 + e] : b2i[(u.pm >= 32 ? 2 * FF : 0) + u.pn * 256 + e];
              E.tv.v[k] = v; }
          int nu = 0; { pg8::Unit u; while (nu < 6 && S.next(nu, u)) ++nu; } E.npairs = 2 * nu; }
        pg8::gemm_phase<pg8::EpiSwiGLU<true>, pg8::StaticOrder, PG8_ALIGN, PG8_SP2>(F.lds + RING_OFF, g, S, E);
        if (BOTH(9)) LOCAL_BAR();
    }
    if (IN(10)) { const int gc = GEMM_C();
        pg8::Gemm g{ZH, (const bf16*)(P.ws + WS_W2O), M, D, FF, 0}; pg8::StaticOrder S; S.init(M, D, F.G, gc, WG_OUT);
        pg8::EpiResid<2> E{nullptr, Xb, nullptr, P.out, mods + 8 * D, NMOD, 0.5f, nullptr};
        pg8::gemm_phase<pg8::EpiResid<2>, pg8::StaticOrder, PG8_ALIGN, PG8_SP2>(F.lds + RING_OFF, g, S, E);
    }
#undef IN
#undef BOTH
}

extern "C" void kernel_launch(void* const* d_in, const int* in_sizes, int n_in, void* d_out, int out_size, void* d_ws, size_t ws_size, hipStream_t stream) {
    static int grid = 0;
    if (grid == 0) {
        if (n_in != 16 || in_sizes[0] != M * D || out_size != M * D || ws_size < WS_END) { fprintf(stderr, "kernel_launch: unexpected shapes (n_in %d, in0 %d, out %d, ws %zu)\n", n_in, n_in > 0 ? in_sizes[0] : -1, out_size, ws_size); grid = -1; return; }
        int dev = 0, cus = 0, per_cu = 0;
        if (hipGetDevice(&dev) != hipSuccess || hipDeviceGetAttribute(&cus, hipDeviceAttributeMultiprocessorCount, dev) != hipSuccess) { grid = -1; return; }
        if (hipFuncSetAttribute((const void*)mk_fwd, hipFuncAttributeMaxDynamicSharedMemorySize, LDS_BYTES) != hipSuccess) { fprintf(stderr, "kernel_launch: hipFuncSetAttribute failed\n"); grid = -1; return; }
        if (hipOccupancyMaxActiveBlocksPerMultiprocessor(&per_cu, (const void*)mk_fwd, NWAVES * 64, LDS_BYTES) != hipSuccess || per_cu < 1) { fprintf(stderr, "kernel_launch: occupancy query says %d blocks per CU\n", per_cu); per_cu = 1; }
        (void)hipGetLastError();
        grid = cus;
        if (grid > 256) grid = 256;
        if ((M / 256) * (2 * FF / 256) > 6 * grid || (M / 256) * (DIN / 256) > 4 * grid) { fprintf(stderr, "kernel_launch: %d CUs: the epilogue tables hold at most 6 (FFN-in) / 4 (mixer-in) units per workgroup\n", grid); grid = -1; return; }
    }
    if (grid < 0) return;
    (void)hipMemsetAsync((char*)d_ws + WS_CTL, 0, CTL_ZERO_BYTES, stream);
    Args a{};
    const float** pp = (const float**)&a.p;
    for (int i = 0; i < 16; ++i) pp[i] = (const float*)d_in[i];
    a.p.out = (float*)d_out; a.p.ws = (unsigned char*)d_ws;
    if (N_LAUNCHES == 1) { a.ph_lo = 0; a.ph_hi = PER_PHASE; a.li = 0; hipLaunchKernelGGL(mk_fwd, dim3(grid), dim3(NWAVES * 64), LDS_BYTES, stream, a); }
    else for (int li = 0; li < PER_PHASE; ++li) { a.ph_lo = li; a.ph_hi = li + 1; a.li = li; hipLaunchKernelGGL(mk_fwd, dim3(grid), dim3(NWAVES * 64), LDS_BYTES, stream, a); }
}
```

```cpp
#include <hip/hip_runtime.h>
#include <cstdio>
#include <cstdint>
#include <hip/hip_bf16.h>
namespace pg8 {
#define PG8_LAS __attribute__((address_space(3)))
typedef unsigned short bf16_t;
typedef short bf16x8 __attribute__((ext_vector_type(8)));
typedef float f32x4 __attribute__((ext_vector_type(4)));
typedef unsigned u32x4 __attribute__((ext_vector_type(4)));
constexpr int BM = 256, BK = 64, HALF = 128, HTB = HALF * BK * 2  , STAGE_BYTES = 8 * HTB, NXCD = 8;

__host__ __device__ __forceinline__ int lds_byte(int r, int c) { const int st = (r >> 4) * 2 + (c >> 5), rr = r & 15, cc = c & 31, ob = rr * 64 + cc * 2; return st * 1024 + (ob ^ (((ob >> 9) & 1) << 5)); }
__host__ __device__ __forceinline__ void stage_rc(int b, int& R, int& C) { const int st = b / 1024, sb = b % 1024, swz = sb ^ (((sb >> 9) & 1) << 5); R = (st >> 1) * 16 + swz / 64; C = (st & 1) * 32 + (swz % 64) / 2; }
__host__ __device__ __forceinline__ int perm32(int rho) { const int n = rho >> 4, i = rho & 15; return 8 * (i >> 2) + 4 * n + (i & 3); }

struct Unit { int pm, pn, idx; };
struct Gemm { const bf16_t* A; const bf16_t* Bt; int M, N, K; size_t bstride; };

struct StaticOrder {
    int nM, nN, nwg, G, c, WGM, ROT;
    __host__ __device__ void init(int M, int N, int G_, int c_, int wgm = 8, int rot = 0) { nM = M / BM; nN = N / BM; nwg = nM * nN; G = G_; c = c_; WGM = wgm; ROT = (G_ == 256) ? rot : 0; }
    __host__ __device__ __forceinline__ int slot(int i) const { const int r = (ROT >> (8 * (i & 3))) & 31; return r ? ((((c >> 3) + r) & 31) << 3) + (c & 7) : c; }
    __host__ __device__ __forceinline__ bool next(int i, Unit& u) const {
        const long L = (long)i * G + slot(i); if (L >= nwg) return false;
        int wgid = (int)L; { const int q = nwg / NXCD, r = nwg % NXCD, xcd = wgid % NXCD, off = wgid / NXCD; wgid = (xcd < r ? xcd * (q + 1) : r * (q + 1) + (xcd - r) * q) + off; }
        const int nig = WGM * nN, gid = wgid / nig, fm = gid * WGM, gsz = (nM - fm) < WGM ? (nM - fm) : WGM;
        u.pm = fm + ((wgid % nig) % gsz); u.pn = (wgid % nig) / gsz; u.idx = i; return true;
    }
    __device__ __forceinline__ void a_ready(const Unit&) const {}
    __device__ __forceinline__ void done(const Unit&) const {}
};

__device__ __forceinline__ unsigned cvt_pk_bf16(float lo, float hi) { unsigned r; asm volatile("v_cvt_pk_bf16_f32 %0, %1, %2" : "=v"(r) : "v"(lo), "v"(hi)); return r; }
typedef float f32x2 __attribute__((ext_vector_type(2)));
__device__ __forceinline__ float sigmoid_f(float x) { return __builtin_amdgcn_rcpf(1.0f + __builtin_amdgcn_exp2f(-1.4426950408889634f * x)); }
__device__ __forceinline__ float silu_f(float x) { return x * sigmoid_f(x); }
__device__ __forceinline__ float bf_lo(unsigned w) { return __builtin_bit_cast(float, w << 16); }
__device__ __forceinline__ float bf_hi(unsigned w) { return __builtin_bit_cast(float, w & 0xffff0000u); }
constexpr int EPT_OFF = 131072;
struct EpiTab {
    float v[6];
    template <int NA> __device__ __forceinline__ void store(PG8_LAS float* tab, int npairs) const { const int t = threadIdx.x;
#pragma unroll
        for (int k = 0; k < 6; ++k) { const int p = 2 * k + (t >> 8), a = p % NA; float x = v[k];
            if (a == 0) x = __builtin_amdgcn_rsqf(x * (1.0f / 1024.0f) + 1e-6f); else if (a == 2) x = 1.0f - x;
            if (p < npairs) tab[p * 256 + (t & 255)] = x; } }
};
template <bool TAB> struct EpiSwiGLU {
    static constexpr bool PERM = true, AFTER_DRAIN = false;
    bf16_t* O; int ldc; PG8_LAS float* tab; int npairs; EpiTab tv;
    __device__ __forceinline__ void post_prologue() const { if constexpr (TAB) tv.store<2>(tab, npairs); }
    __device__ __forceinline__ void operator()(const f32x4 (&acc)[2][2][4][2], const Unit& u, int wr, int wc, int fr, int fq) const {
        const int row0 = u.pm * BM + wr * 64 + fr, col0 = u.pn * HALF + wc * 32 + 8 * fq;
        const float NL2E = -1.4426950408889634f;
        const PG8_LAS float* t = tab + u.idx * 512;
        f32x2 bg[2][2], bu[2][2];
        if constexpr (TAB) {
#pragma unroll
            for (int n = 0; n < 2; ++n) { const f32x4 g4 = *(const PG8_LAS f32x4*)(t + 256 + wc * 32 + 8 * fq + 4 * n), u4 = *(const PG8_LAS f32x4*)(t + 256 + HALF + wc * 32 + 8 * fq + 4 * n);
                bg[n][0] = (f32x2){g4[0], g4[1]}; bg[n][1] = (f32x2){g4[2], g4[3]}; bu[n][0] = (f32x2){u4[0], u4[1]}; bu[n][1] = (f32x2){u4[2], u4[3]}; }
        }
#pragma unroll
        for (int ai = 0; ai < 2; ++ai)
#pragma unroll
            for (int m = 0; m < 4; ++m) { const int row = row0 + ai * HALF + m * 16; bf16_t* rowp = O + (size_t)row * ldc + col0;
                float rs = 1.0f; if constexpr (TAB) rs = t[wr * 64 + fr + ai * HALF + m * 16];
                f32x2 h[4];
#pragma unroll
                for (int n = 0; n < 2; ++n)
#pragma unroll
                    for (int p = 0; p < 2; ++p) { const f32x2 ag = {acc[ai][0][m][n][2 * p], acc[ai][0][m][n][2 * p + 1]}, au = {acc[ai][1][m][n][2 * p], acc[ai][1][m][n][2 * p + 1]};
                        f32x2 g = ag, uu = au; if constexpr (TAB) { g = ag * rs + bg[n][p]; uu = au * rs + bu[n][p]; }
                        const f32x2 tt = g * NL2E;
                        f32x2 d; d.x = __builtin_amdgcn_exp2f(tt.x); d.y = __builtin_amdgcn_exp2f(tt.y); d = d + 1.0f;
                        f32x2 r; r.x = __builtin_amdgcn_rcpf(d.x); r.y = __builtin_amdgcn_rcpf(d.y);
                        h[n * 2 + p] = (g * r) * uu; }
                u32x4 w; w.x = cvt_pk_bf16(h[0].x, h[0].y); w.y = cvt_pk_bf16(h[1].x, h[1].y); w.z = cvt_pk_bf16(h[2].x, h[2].y); w.w = cvt_pk_bf16(h[3].x, h[3].y);
                *(u32x4*)rowp = w; }
    }
};
template <int MODE> struct EpiResid {
    static constexpr bool PERM = true, AFTER_DRAIN = false;
    const float* basef; const bf16_t* baseb; bf16_t* outb; float* outf; const float* gate; int gstride; float sc; float* ss;
    __device__ __forceinline__ void post_prologue() const {}
    __device__ __forceinline__ void operator()(const f32x4 (&acc)[2][2][4][2], const Unit& u, int wr, int wc, int fr, int fq) const {
        const int row0 = u.pm * BM + wr * 64 + fr, col0 = u.pn * BM + wc * 32 + 8 * fq;
        const float* gp = gate + (size_t)(u.pm >= 32 ? gstride : 0) + col0;
        f32x4 gv[2][2];
#pragma unroll
        for (int bj = 0; bj < 2; ++bj)
#pragma unroll
            for (int n = 0; n < 2; ++n) gv[bj][n] = *(const f32x4*)(gp + bj * HALF + 4 * n) * sc;
#pragma unroll
        for (int ai = 0; ai < 2; ++ai) {
            f32x4 bs[4][2][2];
#pragma unroll
            for (int m = 0; m < 4; ++m) { const size_t off = (size_t)(row0 + ai * HALF + m * 16) * 1024 + col0;
#pragma unroll
                for (int bj = 0; bj < 2; ++bj) {
                    if (MODE == 0) { bs[m][bj][0] = __builtin_nontemporal_load((const f32x4*)(basef + off + bj * HALF)); bs[m][bj][1] = __builtin_nontemporal_load((const f32x4*)(basef + off + bj * HALF + 4)); }
                    else { const u32x4 w = *(const u32x4*)(baseb + off + bj * HALF);
                        bs[m][bj][0] = (f32x4){bf_lo(w.x), bf_hi(w.x), bf_lo(w.y), bf_hi(w.y)}; bs[m][bj][1] = (f32x4){bf_lo(w.z), bf_hi(w.z), bf_lo(w.w), bf_hi(w.w)}; } } }
#pragma unroll
            for (int m = 0; m < 4; ++m) { const int row = row0 + ai * HALF + m * 16; const size_t off = (size_t)row * 1024 + col0; float sq = 0.f;
#pragma unroll
                for (int bj = 0; bj < 2; ++bj) { const f32x4 v0 = bs[m][bj][0] + gv[bj][0] * acc[ai][bj][m][0], v1 = bs[m][bj][1] + gv[bj][1] * acc[ai][bj][m][1];
                    if (MODE == 2) { *(f32x4*)(outf + off + bj * HALF) = v0; *(f32x4*)(outf + off + bj * HALF + 4) = v1; }
                    else { u32x4 w; w.x = cvt_pk_bf16(v0[0], v0[1]); w.y = cvt_pk_bf16(v0[2], v0[3]); w.z = cvt_pk_bf16(v1[0], v1[1]); w.w = cvt_pk_bf16(v1[2], v1[3]);
                        *(u32x4*)(outb + off + bj * HALF) = w;
                        sq += (v0[0] * v0[0] + v0[1] * v0[1]) + (v0[2] * v0[2] + v0[3] * v0[3]) + (v1[0] * v1[0] + v1[1] * v1[1]) + (v1[2] * v1[2] + v1[3] * v1[3]); } }
                if (MODE != 2) { sq += __shfl_xor(sq, 16); sq += __shfl_xor(sq, 32); if (fq == 0) atomicAdd(ss + row, sq); } }
            asm volatile("" ::: "memory");
        }
    }
};
struct EpiMixIn {
    static constexpr bool PERM = true, AFTER_DRAIN = false;
    bf16_t* O; PG8_LAS float* tab; int npairs; EpiTab tv;
    __device__ __forceinline__ void post_prologue() const { tv.store<3>(tab, npairs); }
    __device__ __forceinline__ void operator()(const f32x4 (&acc)[2][2][4][2], const Unit& u, int wr, int wc, int fr, int fq) const {
        const int row0 = u.pm * BM + wr * 64 + fr, col0 = u.pn * BM + wc * 32 + 8 * fq;
        const int kind = (u.pn < 2) ? 1 : (u.pn < 6) ? 2 : (u.pn < 8) ? 0 : (u.pn < 10) ? 1 : 0;
        const float L2E = 1.4426950408889634f;
        const PG8_LAS float* t = tab + u.idx * 768;
        f32x2 oml[2][4], bv[2][4];
#pragma unroll
        for (int bj = 0; bj < 2; ++bj)
#pragma unroll
            for (int n = 0; n < 2; ++n) { const int c = wc * 32 + 8 * fq + bj * HALF + 4 * n;
                const f32x4 b4 = *(const PG8_LAS f32x4*)(t + 256 + c), l4 = *(const PG8_LAS f32x4*)(t + 512 + c);
                bv[bj][2 * n] = (f32x2){b4[0], b4[1]}; bv[bj][2 * n + 1] = (f32x2){b4[2], b4[3]};
                oml[bj][2 * n] = (f32x2){l4[0], l4[1]}; oml[bj][2 * n + 1] = (f32x2){l4[2], l4[3]}; }
        const float sg = (kind == 2) ? L2E : -L2E;
#pragma unroll
        for (int ai = 0; ai < 2; ++ai)
#pragma unroll
            for (int m = 0; m < 4; ++m) { const int row = row0 + ai * HALF + m * 16; bf16_t* rowp = O + (size_t)row * 3328 + col0;
                const float rs = t[wr * 64 + fr + ai * HALF + m * 16];
#pragma unroll
                for (int bj = 0; bj < 2; ++bj) { f32x2 h[4];
#pragma unroll
                    for (int q = 0; q < 4; ++q) { const f32x2 a = {acc[ai][bj][m][q >> 1][2 * (q & 1)], acc[ai][bj][m][q >> 1][2 * (q & 1) + 1]};
                        const f32x2 z = a * rs + bv[bj][q];
                        if (kind == 0) h[q] = z;
                        else { const f32x2 tt = z * sg;
                            f32x2 d; d.x = __builtin_amdgcn_exp2f(tt.x); d.y = __builtin_amdgcn_exp2f(tt.y); d = d + 1.0f;
                            f32x2 r; r.x = __builtin_amdgcn_rcpf(d.x); r.y = __builtin_amdgcn_rcpf(d.y);
                            if (kind == 1) h[q] = z * r;
                            else { const f32x2 f = 1.0f - oml[bj][q] * r;
                                f32x2 lg; lg.x = __builtin_amdgcn_logf(f.x); lg.y = __builtin_amdgcn_logf(f.y); h[q] = lg * 0.6931471805599453f; } } }
                    u32x4 w; w.x = cvt_pk_bf16(h[0].x, h[0].y); w.y = cvt_pk_bf16(h[1].x, h[1].y); w.z = cvt_pk_bf16(h[2].x, h[2].y); w.w = cvt_pk_bf16(h[3].x, h[3].y);
                    *(u32x4*)(rowp + bj * HALF) = w; } }
    }
};
template <class Epi, class Sched, bool ALIGN_EPI = false, bool SP2 = false>
__device__ __forceinline__ void gemm_phase(PG8_LAS unsigned char* lds, const Gemm g, const Sched& S, const Epi& E) {
    const int tid = threadIdx.x, wid = __builtin_amdgcn_readfirstlane(tid >> 6), lane = tid & 63, wr = wid >> 2, wc = wid & 3, fr = lane & 15, fq = lane >> 4;
    const int K = g.K, nt = K / BK;
    unsigned voffA[2], voffB[2];
#pragma unroll
    for (int i = 0; i < 2; ++i) { int R, C; stage_rc(tid * 16 + i * 8192, R, C); const int Rb = Epi::PERM ? ((R & ~31) + perm32(R & 31)) : R;
        voffA[i] = (unsigned)(R * K + C) * 2u; voffB[i] = (unsigned)(Rb * K + C) * 2u; }
    const size_t kstep = (size_t)(BK * 2);
    const size_t hstep = (size_t)HALF * K * 2;
    const size_t tstep = 2 * hstep;
    const unsigned ldsw = (unsigned)wid * 1024u;
    const int aoff = lds_byte(wr * 64 + fr, fq * 8), boff = lds_byte(wc * 32 + fr, fq * 8);
#define PG8_SA(b, h) (((b) * 2 + (h)) * HTB)
#define PG8_SB(b, h) ((4 + (b) * 2 + (h)) * HTB)
#define PG8_STAGE(bufoff, gbase, voff) do { _Pragma("unroll") for (int _i = 0; _i < 2; ++_i) \
        __builtin_amdgcn_global_load_lds((const unsigned*)((const char*)(gbase) + (voff)[_i]), (PG8_LAS unsigned*)(lds + (bufoff) + ldsw + _i * 8192), 16, 0, 0); } while (0)
#define PG8_LDA(dst, b, h) do { _Pragma("unroll") for (int m = 0; m < 4; ++m) _Pragma("unroll") for (int k = 0; k < 2; ++k) dst[m][k] = *(const PG8_LAS bf16x8*)(lds + PG8_SA(b, h) + aoff + m * 2048 + k * 1024); } while (0)
#define PG8_LDB(dst, b, h) do { _Pragma("unroll") for (int n = 0; n < 2; ++n) _Pragma("unroll") for (int k = 0; k < 2; ++k) dst[n][k] = *(const PG8_LAS bf16x8*)(lds + PG8_SB(b, h) + boff + n * 2048 + k * 1024); } while (0)
#define PG8_MMA(ai, bj, At, Bt) do { __builtin_amdgcn_s_setprio(1); _Pragma("unroll") for (int m = 0; m < 4; ++m) _Pragma("unroll") for (int n = 0; n < 2; ++n) _Pragma("unroll") for (int k = 0; k < 2; ++k) \
        acc[ai][bj][m][n] = __builtin_amdgcn_mfma_f32_16x16x32_bf16(Bt[n][k], At[m][k], acc[ai][bj][m][n], 0, 0, 0); __builtin_amdgcn_s_setprio(0); } while (0)
#define PG8_WAIT_V(n) asm volatile("s_waitcnt vmcnt(" #n ")" ::: "memory")
#define PG8_WAIT_L(n) asm volatile("s_waitcnt lgkmcnt(" #n ")" ::: "memory")
#define PG8_BAR __builtin_amdgcn_s_barrier()
#define PG8_SCHED __builtin_amdgcn_sched_barrier(0)
    Unit cur, nxt; int ui = 0;
    if (!S.next(0, cur)) return;
    f32x4 acc[2][2][4][2];
#pragma unroll
    for (int a = 0; a < 2; ++a)
#pragma unroll
        for (int b = 0; b < 2; ++b)
#pragma unroll
            for (int m = 0; m < 4; ++m)
#pragma unroll
                for (int n = 0; n < 2; ++n) { f32x2 z0, z1; asm volatile("v_mov_b64 %0, 0" : "=v"(z0)); asm volatile("v_mov_b64 %0, 0" : "=v"(z1)); acc[a][b][m][n] = (f32x4){z0.x, z0.y, z1.x, z1.y}; }
    bf16x8 At[4][2], B0[2][2], B1[2][2];
    const char* cA = (const char*)g.A + (size_t)cur.pm * tstep; const char* cB = (const char*)g.Bt + (size_t)cur.pn * tstep + (cur.pm >= 32 ? g.bstride : (size_t)0);
    S.a_ready(cur);
    if constexpr (SP2) {
        PG8_STAGE(PG8_SB(0, 0), cB, voffB); PG8_STAGE(PG8_SB(0, 1), cB + hstep, voffB); PG8_STAGE(PG8_SA(0, 0), cA, voffA); PG8_STAGE(PG8_SA(0, 1), cA + hstep, voffA);
        PG8_STAGE(PG8_SB(1, 0), cB + kstep, voffB); PG8_STAGE(PG8_SA(1, 0), cA + kstep, voffA); PG8_STAGE(PG8_SB(1, 1), cB + hstep + kstep, voffB);
        if (wr == 1) PG8_BAR;
        PG8_WAIT_V(8); PG8_BAR;
        PG8_WAIT_V(6); PG8_BAR;
    } else {
        PG8_STAGE(PG8_SB(0, 0), cB, voffB); PG8_STAGE(PG8_SA(0, 0), cA, voffA); PG8_STAGE(PG8_SB(0, 1), cB + hstep, voffB); PG8_STAGE(PG8_SA(0, 1), cA + hstep, voffA);
        if (wr == 1) PG8_BAR;
        PG8_WAIT_V(4); PG8_BAR;
        PG8_STAGE(PG8_SB(1, 0), cB + kstep, voffB); PG8_STAGE(PG8_SA(1, 0), cA + kstep, voffA); PG8_STAGE(PG8_SB(1, 1), cB + hstep + kstep, voffB);
        PG8_WAIT_V(6); PG8_BAR;
    }
    E.post_prologue();
    for (;;) {
        const bool has_next = S.next(ui + 1, nxt);
        const char* nA = has_next ? (const char*)g.A + (size_t)nxt.pm * tstep : cA + (size_t)(nt - 2) * kstep; const char* nB = has_next ? (const char*)g.Bt + (size_t)nxt.pn * tstep + (nxt.pm >= 32 ? g.bstride : (size_t)0) : cB + (size_t)(nt - 2) * kstep;
        for (int t = 0; t < nt; t += 2) {
            const bool last = (t == nt - 2);
            const char* a1 = cA + (size_t)(t + 1) * kstep;
            const char* a2 = last ? nA : cA + (size_t)(t + 2) * kstep; const char* b2 = last ? nB : cB + (size_t)(t + 2) * kstep;
            const char* a3 = a2 + kstep; const char* b3 = b2 + kstep;
            if (last && has_next) S.a_ready(nxt);
            if constexpr (SP2) {
            PG8_LDB(B0, 0, 0); PG8_LDB(B1, 0, 1); PG8_SCHED; PG8_LDA(At, 0, 0); PG8_STAGE(PG8_SA(1, 1), a1 + hstep, voffA);
            PG8_WAIT_V(8); PG8_WAIT_L(0); PG8_BAR; PG8_MMA(0, 0, At, B0); PG8_MMA(0, 1, At, B1); PG8_BAR; PG8_SCHED;
            PG8_LDA(At, 0, 1); PG8_STAGE(PG8_SB(0, 0), b2, voffB); PG8_STAGE(PG8_SB(0, 1), b2 + hstep, voffB); PG8_STAGE(PG8_SA(0, 0), a2, voffA);
            PG8_WAIT_V(8); PG8_WAIT_L(0); PG8_BAR; PG8_MMA(1, 0, At, B0); PG8_MMA(1, 1, At, B1); PG8_BAR; PG8_SCHED;
            PG8_LDB(B0, 1, 0); PG8_LDB(B1, 1, 1); PG8_SCHED; PG8_LDA(At, 1, 0); PG8_STAGE(PG8_SA(0, 1), a2 + hstep, voffA);
            PG8_WAIT_V(8); PG8_WAIT_L(0); PG8_BAR; PG8_MMA(0, 0, At, B0); PG8_MMA(0, 1, At, B1); PG8_BAR; PG8_SCHED;
            PG8_LDA(At, 1, 1); PG8_STAGE(PG8_SB(1, 0), b3, voffB); PG8_STAGE(PG8_SB(1, 1), b3 + hstep, voffB); PG8_STAGE(PG8_SA(1, 0), a3, voffA);
            PG8_WAIT_V(8); PG8_WAIT_L(0); PG8_BAR; PG8_MMA(1, 0, At, B0); PG8_MMA(1, 1, At, B1); PG8_BAR; PG8_SCHED;
            } else {
            PG8_LDB(B0, 0, 0); PG8_SCHED; PG8_LDA(At, 0, 0); PG8_STAGE(PG8_SA(1, 1), a1 + hstep, voffA);
            PG8_WAIT_L(8); PG8_BAR; PG8_WAIT_L(0); PG8_MMA(0, 0, At, B0); PG8_BAR; PG8_SCHED;
            PG8_LDB(B1, 0, 1); PG8_STAGE(PG8_SB(0, 0), b2, voffB);
            PG8_BAR; PG8_WAIT_L(0); PG8_MMA(0, 1, At, B1); PG8_BAR;
            PG8_LDA(At, 0, 1); PG8_STAGE(PG8_SA(0, 0), a2, voffA);
            PG8_BAR; PG8_WAIT_L(0); PG8_MMA(1, 0, At, B0); PG8_BAR; PG8_SCHED;
            PG8_STAGE(PG8_SB(0, 1), b2 + hstep, voffB);
            PG8_WAIT_V(6); PG8_BAR; PG8_MMA(1, 1, At, B1); PG8_BAR;
            PG8_LDB(B0, 1, 0); PG8_SCHED; PG8_LDA(At, 1, 0); PG8_STAGE(PG8_SA(0, 1), a2 + hstep, voffA);
            PG8_WAIT_L(8); PG8_BAR; PG8_WAIT_L(0); PG8_MMA(0, 0, At, B0); PG8_BAR; PG8_SCHED;
            PG8_LDB(B1, 1, 1); PG8_STAGE(PG8_SB(1, 0), b3, voffB);
            PG8_BAR; PG8_WAIT_L(0); PG8_MMA(0, 1, At, B1); PG8_BAR;
            PG8_LDA(At, 1, 1); PG8_STAGE(PG8_SA(1, 0), a3, voffA);
            PG8_BAR; PG8_WAIT_L(0); PG8_MMA(1, 0, At, B0); PG8_BAR; PG8_SCHED;
            PG8_STAGE(PG8_SB(1, 1), b3 + hstep, voffB);
            PG8_WAIT_V(6); PG8_BAR; PG8_MMA(1, 1, At, B1); PG8_BAR;
            }
        }
        if constexpr (ALIGN_EPI) { if (wr == 0) PG8_BAR; }
        if constexpr (!Epi::AFTER_DRAIN) { E(acc, cur, wr, wc, fr, fq); S.done(cur); }
        if (!has_next) break;
#pragma unroll
        for (int a = 0; a < 2; ++a)
#pragma unroll
            for (int b = 0; b < 2; ++b)
#pragma unroll
                for (int m = 0; m < 4; ++m)
#pragma unroll
                    for (int n = 0; n < 2; ++n) { f32x2 z0, z1; asm volatile("v_mov_b64 %0, 0" : "=v"(z0)); asm volatile("v_mov_b64 %0, 0" : "=v"(z1)); acc[a][b][m][n] = (f32x4){z0.x, z0.y, z1.x, z1.y}; }
        cur = nxt; cA = nA; cB = nB; ++ui;
        if constexpr (ALIGN_EPI) { if (wr == 1) PG8_BAR; }
    }
    PG8_WAIT_V(0);
    if constexpr (!ALIGN_EPI) { if (wr == 0) PG8_BAR; }
    PG8_BAR;
    if constexpr (Epi::AFTER_DRAIN) { E.fused(acc, cur, wr, wc, fr, fq, lds, wid, lane); S.done(cur); }
#undef PG8_SA
#undef PG8_SB
#undef PG8_STAGE
#undef PG8_LDA
#undef PG8_LDB
#undef PG8_MMA
#undef PG8_WAIT_V
#undef PG8_WAIT_L
#undef PG8_BAR
#undef PG8_SCHED
}
}

#ifndef PG8_SP2
#define PG8_SP2 true
#endif
#ifndef PG8_ALIGN
#define PG8_ALIGN true
#endif
#define GAS __attribute__((address_space(1)))
#define LAS __attribute__((address_space(3)))
typedef unsigned short bf16;
typedef unsigned v4u __attribute__((ext_vector_type(4)));
typedef float f32x4 __attribute__((ext_vector_type(4)));
typedef short bf16x8 __attribute__((ext_vector_type(8)));
typedef GAS unsigned gu32;
typedef GAS unsigned long long gu64;
#define RLX_AGENT __ATOMIC_RELAXED, __HIP_MEMORY_SCOPE_AGENT
#define LDS_WAIT() asm volatile("s_waitcnt lgkmcnt(0)" ::: "memory")
#define VM_WAIT() asm volatile("s_waitcnt vmcnt(0)" ::: "memory")
__device__ __forceinline__ unsigned long long rt() { return __builtin_amdgcn_s_memrealtime(); }
__device__ __forceinline__ unsigned f2bf(float f) { unsigned u = __builtin_bit_cast(unsigned, f); return (u + 0x7fffu + ((u >> 16) & 1u)) >> 16; }
__device__ __forceinline__ unsigned pk2(float lo, float hi) { return f2bf(lo) | (f2bf(hi) << 16); }

#define XB_TMO      128
#define XB_XCNT(j)  (256  + 64 * (j))
#define XB_XSUB(j)  (1280 + 64 * (j))
#define XB_XGEN(j)  (2304 + 64 * (j))
#define XB_TOP      3328
#define XB_TOPGEN   3392
#define XB_LSUB(j)  (3456 + 64 * (j))
#define XB_LGEN(j)  (4480 + 64 * (j))
#define XCD_BAR_WORDS 5504
#define XB_SPIN_CAP (1u << 18)

__device__ __forceinline__ unsigned xb_ld(unsigned* p)              { return __hip_atomic_load(p, __ATOMIC_RELAXED, __HIP_MEMORY_SCOPE_AGENT); }
__device__ __forceinline__ unsigned xb_add(unsigned* p, unsigned v) { return __hip_atomic_fetch_add(p, v, __ATOMIC_RELAXED, __HIP_MEMORY_SCOPE_AGENT); }
__device__ __forceinline__ unsigned xb_xcc_id() { return (unsigned)__builtin_amdgcn_s_getreg((3 << 11) | 20) & 0xFu; }
#define XB_SPIN(cond, bar) do { unsigned _sp = 0; while (cond) { __builtin_amdgcn_s_sleep(1); \
    if ((++_sp & 255u) == 0u) { if (xb_ld(&(bar)[XB_TMO])) break; if (_sp > XB_SPIN_CAP) { atomicAdd(&(bar)[XB_TMO], 1u); break; } } } } while (0)

struct XcdBarrier {
    unsigned* bar; unsigned x;
    volatile LAS unsigned* st;
};

__device__ __forceinline__ XcdBarrier xcd_barrier_post(unsigned* bar, volatile LAS unsigned* st) {
    XcdBarrier b; b.bar = bar; b.x = xb_xcc_id(); b.st = st;
    if (threadIdx.x == 0) st[4] = xb_add(&bar[XB_XCNT(b.x)], 1u);
    return b;
}
__device__ __forceinline__ void xcd_barrier_complete(unsigned* bar, unsigned x, unsigned& nloc, unsigned& nx, unsigned& balanced) {
    const unsigned G = gridDim.x * gridDim.y * gridDim.z;
    unsigned sum, cnt, mine, sp = 0u, even;
    for (;;) {
        sum = 0u; cnt = 0u; mine = 0u; even = 1u;
#pragma unroll
        for (unsigned j = 0; j < 16; ++j) { const unsigned c = xb_ld(&bar[XB_XCNT(j)]); sum += c; cnt += (c > 0u) ? 1u : 0u; mine = (j == x) ? c : mine; even &= (j < 8u ? c * 8u == G : c == 0u) ? 1u : 0u; }
        if (sum == G) break;
        __builtin_amdgcn_s_sleep(1);
        if ((++sp & 255u) == 0u) { if (xb_ld(&bar[XB_TMO])) break; if (sp > XB_SPIN_CAP) { atomicAdd(&bar[XB_TMO], 1u); break; } }
    }
    nloc = mine > 0u ? mine : 1u; nx = cnt > 0u ? cnt : 1u;
    balanced = (sum == G && even && cnt == 8u) ? 1u : 2u;
}

__device__ __forceinline__ void xcd_barrier(const XcdBarrier& b) {
    asm volatile("s_waitcnt vmcnt(0)" ::: "memory");
    __syncthreads();
    if (threadIdx.x == 0) {
        unsigned* bar = b.bar;
        __builtin_amdgcn_s_waitcnt(0);
        unsigned nloc = b.st[0], nx = b.st[1];
        if (nloc == 0u) { unsigned bal; xcd_barrier_complete(bar, b.x, nloc, nx, bal); b.st[0] = nloc; b.st[1] = nx; b.st[5] = bal; }
        const unsigned old = xb_add(&bar[XB_XSUB(b.x)], 1u);
        const unsigned gen = old / nloc;
        if (old + 1u == (gen + 1u) * nloc) {
            __builtin_amdgcn_fence(__ATOMIC_RELEASE, "agent");
            asm volatile("s_waitcnt vmcnt(0)" ::: "memory");
            const unsigned og = xb_add(&bar[XB_TOP], 1u);
            const unsigned tg = og / nx;
            if (og + 1u == (tg + 1u) * nx) {
#pragma unroll
                for (unsigned j = 0; j < 16; ++j) (void)__hip_atomic_fetch_add(&bar[XB_XGEN(j)], 1u, __ATOMIC_RELAXED, __HIP_MEMORY_SCOPE_AGENT);
            }
        }
        XB_SPIN(xb_ld(&bar[XB_XGEN(b.x)]) == gen, bar);
        __builtin_amdgcn_fence(__ATOMIC_ACQUIRE, "agent");
        asm volatile("s_waitcnt vmcnt(0)" ::: "memory");
    }
    __syncthreads();
}
__device__ __forceinline__ void xcd_local_barrier(const XcdBarrier& b) {
    asm volatile("s_waitcnt vmcnt(0)" ::: "memory");
    __syncthreads();
    if (threadIdx.x == 0) {
        unsigned* bar = b.bar;
        __builtin_amdgcn_s_waitcnt(0);
        const unsigned nloc = b.st[0];
        const unsigned old = xb_add(&bar[XB_LSUB(b.x)], 1u);
        const unsigned gen = old / nloc;
        if (old + 1u == (gen + 1u) * nloc) xb_add(&bar[XB_LGEN(b.x)], 1u);
        else XB_SPIN(xb_ld(&bar[XB_LGEN(b.x)]) == gen, bar);
        __builtin_amdgcn_fence(__ATOMIC_ACQUIRE, "agent");
        asm volatile("s_waitcnt vmcnt(0)" ::: "memory");
    }
    __syncthreads();
}
using pg8::silu_f; using pg8::sigmoid_f;
__device__ __forceinline__ void xcd_barrier_arrive(const XcdBarrier& b) {
    asm volatile("s_waitcnt vmcnt(0)" ::: "memory");
    __syncthreads();
    if (threadIdx.x == 0) {
        unsigned* bar = b.bar;
        __builtin_amdgcn_s_waitcnt(0);
        unsigned nloc = b.st[0], nx = b.st[1];
        if (nloc == 0u) { unsigned bal; xcd_barrier_complete(bar, b.x, nloc, nx, bal); b.st[0] = nloc; b.st[1] = nx; b.st[5] = bal; }
        const unsigned old = xb_add(&bar[XB_XSUB(b.x)], 1u);
        const unsigned gen = old / nloc;
        if (old + 1u == (gen + 1u) * nloc) {
            __builtin_amdgcn_fence(__ATOMIC_RELEASE, "agent");
            asm volatile("s_waitcnt vmcnt(0)" ::: "memory");
            const unsigned og = xb_add(&bar[XB_TOP], 1u);
            const unsigned tg = og / nx;
            if (og + 1u == (tg + 1u) * nx) {
#pragma unroll
                for (unsigned j = 0; j < 16; ++j) (void)__hip_atomic_fetch_add(&bar[XB_XGEN(j)], 1u, __ATOMIC_RELAXED, __HIP_MEMORY_SCOPE_AGENT);
            }
        }
        b.st[3] = gen;
    }
}
__device__ __forceinline__ void xcd_barrier_wait(const XcdBarrier& b) {
    asm volatile("s_waitcnt vmcnt(0)" ::: "memory");
    __syncthreads();
    if (threadIdx.x == 0) {
        unsigned* bar = b.bar;
        const unsigned g = b.st[3];
        XB_SPIN(xb_ld(&bar[XB_XGEN(b.x)]) == g, bar);
        __builtin_amdgcn_fence(__ATOMIC_ACQUIRE, "agent");
        asm volatile("s_waitcnt vmcnt(0)" ::: "memory");
    }
    __syncthreads();
}

constexpr int NWAVES = 8;
#ifndef MK_N_LAUNCHES
#define MK_N_LAUNCHES 1
#endif
constexpr int PER_PHASE = 11;
#ifndef WG_IN
#define WG_IN 4
#endif
#ifndef WG_OUT
#define WG_OUT 4
#endif
constexpr int N_LAUNCHES = MK_N_LAUNCHES;

constexpr int T = 8192, D = 1024, FF = 2816, M = 2 * T, DIN = 3328, NMOD = 9 * D;
constexpr float EPS = 1e-6f;
constexpr int ZC_Q = 0, ZC_GF = 512, ZC_GB = 1024, ZC_V = 1536, ZC_GATE = 2048, ZC_AQ = 2560, ZC_AK = 3072, ZC_AV = 3200;

constexpr size_t MiB = 1u << 20;
constexpr size_t WS_CTL = 0, CTL_ZERO_BYTES = 448 * 1024;
constexpr size_t WS_MODS = 64 * 1024;
constexpr size_t WS_SS1 = 192 * 1024, WS_SS2 = 256 * 1024;
constexpr size_t WS_BMI = 320 * 1024;
constexpr size_t WS_B2I = 384 * 1024;
constexpr size_t WS_LB = 1 * MiB;
constexpr size_t WS_W1I = 2 * MiB, WS_W1O = 13 * MiB, WS_W2O = 19 * MiB, WS_WMO = 25 * MiB, WS_WMI = 27 * MiB, WS_W2I = 40 * MiB;
constexpr size_t WS_X = 62 * MiB;
constexpr size_t WS_H = 94 * MiB;
constexpr size_t WS_MIX = WS_H;
constexpr size_t WS_ZH = 126 * MiB;
constexpr size_t WS_SLOC = 230 * MiB;
constexpr size_t WS_SIN = 246 * MiB;
constexpr size_t WS_DSEG = 254 * MiB;
constexpr size_t WS_END = 256 * MiB;
static_assert(WS_MODS + 2 * 9216 * 4 <= WS_SS1 && WS_SS1 + 16384 * 4 <= WS_SS2 && WS_SS2 + 16384 * 4 <= WS_BMI && WS_BMI + 2 * 3328 * 4 <= WS_B2I && WS_B2I + 2 * 5632 * 4 <= CTL_ZERO_BYTES, "zeroed region");
static_assert(WS_W1I + (size_t)2 * FF * D * 2 <= WS_W1O && WS_W1O + (size_t)D * FF * 2 <= WS_W2O && WS_W2O + (size_t)D * FF * 2 <= WS_WMO && WS_WMO + (size_t)D * D * 2 <= WS_WMI &&
              WS_WMI + (size_t)2 * DIN * D * 2 <= WS_W2I && WS_W2I + (size_t)4 * FF * D * 2 <= WS_X && WS_X + (size_t)M * D * 2 <= WS_H && WS_H + (size_t)M * D * 2 <= WS_ZH && WS_ZH + (size_t)M * DIN * 2 <= WS_SLOC, "d_ws map");
constexpr int CW_TMO = 0, CW_CODE = 1, CW_BAR = 4096;

constexpr int RING_OFF = 0, RING_BYTES = 147456;
constexpr int LDSCTL_OFF = RING_BYTES, MISC_OFF = LDSCTL_OFF + 320;
constexpr int LDS_BYTES = 151552;
static_assert(MISC_OFF + 128 <= LDS_BYTES, "LDS map");

struct Frame {
    LAS unsigned char* lds;
    volatile LAS unsigned* MISC;
    gu32* ctl;
    int tid, lane, wave;
    int vcu, G;
};

__device__ __forceinline__ float wave_sum(float v) {
#pragma unroll
    for (int o = 1; o < 64; o <<= 1) v += __shfl_xor(v, o);
    return v;
}
__device__ __forceinline__ float bf2f(bf16 v) { return __builtin_bit_cast(float, (unsigned)v << 16); }
__device__ __forceinline__ float bflo(unsigned w) { return __builtin_bit_cast(float, w << 16); }
__device__ __forceinline__ float bfhi(unsigned w) { return __builtin_bit_cast(float, w & 0xffff0000u); }

__device__ __forceinline__ void p0_transpose_item(const float* W, int K, int N, bf16* WT, int k0, int n0, int dst_row0, LAS float* scr, int lane) {
#pragma unroll 8
    for (int i = 0; i < 32; ++i) { const int kk = 2 * i + (lane >> 5); scr[kk * 33 + (lane & 31)] = __builtin_nontemporal_load(W + (size_t)(k0 + kk) * N + n0 + (lane & 31)); }
    LDS_WAIT(); asm volatile("" ::: "memory");
    const int c = lane & 7;
#pragma unroll
    for (int j = 0; j < 4; ++j) { const int n = (lane >> 3) + 8 * j; const LAS float* s = scr + (8 * c) * 33 + n;
        v4u o; o.x = pk2(s[0 * 33], s[1 * 33]); o.y = pk2(s[2 * 33], s[3 * 33]); o.z = pk2(s[4 * 33], s[5 * 33]); o.w = pk2(s[6 * 33], s[7 * 33]);
        *(GAS v4u*)(WT + (size_t)(dst_row0 + n) * K + k0 + 8 * c) = o; }
    LDS_WAIT(); asm volatile("" ::: "memory");
}
__device__ __forceinline__ void p0_transpose_mod(const float* W, int K, int N, bf16* WT, size_t bstride_el, int k0, int n0, int dst_row0, LAS float* scr, const LAS float* AB, float* bias, int bias_stride, int lane) {
#pragma unroll 8
    for (int i = 0; i < 32; ++i) { const int kk = 2 * i + (lane >> 5); scr[kk * 33 + (lane & 31)] = __builtin_nontemporal_load(W + (size_t)(k0 + kk) * N + n0 + (lane & 31)); }
    LDS_WAIT(); asm volatile("" ::: "memory");
    const int c = lane & 7;
    float a0[8], a1[8], s0[8], s1[8];
#pragma unroll
    for (int i = 0; i < 8; ++i) { a0[i] = AB[0 * 1024 + k0 + 8 * c + i]; s0[i] = AB[1 * 1024 + k0 + 8 * c + i]; a1[i] = AB[2 * 1024 + k0 + 8 * c + i]; s1[i] = AB[3 * 1024 + k0 + 8 * c + i]; }
#pragma unroll
    for (int j = 0; j < 4; ++j) { const int n = (lane >> 3) + 8 * j; const LAS float* s = scr + (8 * c) * 33 + n;
        float w[8]; float b0 = 0.f, b1 = 0.f;
#pragma unroll
        for (int i = 0; i < 8; ++i) { w[i] = s[i * 33]; b0 += s0[i] * w[i]; b1 += s1[i] * w[i]; }
        v4u o; o.x = pk2(w[0] * a0[0], w[1] * a0[1]); o.y = pk2(w[2] * a0[2], w[3] * a0[3]); o.z = pk2(w[4] * a0[4], w[5] * a0[5]); o.w = pk2(w[6] * a0[6], w[7] * a0[7]);
        *(GAS v4u*)(WT + (size_t)(dst_row0 + n) * K + k0 + 8 * c) = o;
        o.x = pk2(w[0] * a1[0], w[1] * a1[1]); o.y = pk2(w[2] * a1[2], w[3] * a1[3]); o.z = pk2(w[4] * a1[4], w[5] * a1[5]); o.w = pk2(w[6] * a1[6], w[7] * a1[7]);
        *(GAS v4u*)(WT + bstride_el + (size_t)(dst_row0 + n) * K + k0 + 8 * c) = o;
        b0 += __shfl_xor(b0, 1); b0 += __shfl_xor(b0, 2); b0 += __shfl_xor(b0, 4); b1 += __shfl_xor(b1, 1); b1 += __shfl_xor(b1, 2); b1 += __shfl_xor(b1, 4);
        if (c == 0) { atomicAdd(bias + dst_row0 + n, b0); atomicAdd(bias + bias_stride + dst_row0 + n, b1); } }
    LDS_WAIT(); asm volatile("" ::: "memory");
}
__device__ __forceinline__ void p0_transpose_nat(const float* W, int K, int N, bf16* WT, LAS float* scr, int item, int lane) {
    const int nblk = N / 32, kb = item / nblk, nb = item % nblk;
    p0_transpose_item(W, K, N, WT, 64 * kb, 32 * nb, 32 * nb, scr, lane);
}
__device__ __forceinline__ int glu_row(int n0) { const int up = n0 >= FF, nn = n0 - (up ? FF : 0); return 256 * (nn >> 7) + (up ? 128 : 0) + (nn & 127); }
__device__ __forceinline__ void p0_transpose_glu(const float* W, bf16* WT, LAS float* scr, int item, int lane) {
    const int nblk = (2 * FF) / 32, kb = item / nblk, nb = item % nblk, n0 = 32 * nb;
    p0_transpose_item(W, D, 2 * FF, WT, 64 * kb, n0, glu_row(n0), scr, lane);
}
__device__ __forceinline__ int t5_bucket(int rel) {
    const int n = rel < 0 ? -rel : rel; int r = rel > 0 ? 16 : 0;
    if (n < 8) return r + n;
    return r + 8 + (n >= 12) + (n >= 16) + (n >= 23) + (n >= 32) + (n >= 46) + (n >= 64) + (n >= 91);
}

struct Ptrs {
    const float *x, *c, *w_ada, *b_ada, *norm_g, *w1i, *w1o, *w2i, *w2o, *wmi, *wmo, *hlb, *hng, *qkg, *sink, *relb;
    float* out; unsigned char* ws;
};

template <int RW, int SEL> __device__ __forceinline__ void adaln_gemv(Frame& F, const Ptrs& P) {
    float* mods = (float*)(P.ws + WS_MODS);
    constexpr int NKS = 1024 / (8 * RW), NG = SEL == 0 ? 16 : SEL == 1 ? 12 : 8;
    for (int it = blockIdx.x; it < NG * NKS; it += F.G) {
        const int g = it % NG, ks = it / NG, k0 = ks * (8 * RW) + F.wave * RW;
        const int cg = SEL == 0 ? (g < 8 ? g : g + 4) : SEL == 1 ? (g < 4 ? 8 + g : 20 + g) : (g < 4 ? 20 + g : 28 + g);
        f32x4 a0 = {0.f, 0.f, 0.f, 0.f}, a1 = {0.f, 0.f, 0.f, 0.f};
        const float* wp = P.w_ada + (size_t)k0 * NMOD + cg * 256 + 4 * F.lane;
#pragma unroll
        for (int r = 0; r < RW; ++r) { const f32x4 w = __builtin_nontemporal_load((const f32x4*)(wp + (size_t)r * NMOD));
            const float c0 = P.c[k0 + r], c1 = P.c[D + k0 + r];
            a0 += w * silu_f(c0); a1 += w * silu_f(c1); }
        LAS f32x4* red = (LAS f32x4*)F.lds;
        red[(F.wave * 2 + 0) * 64 + F.lane] = a0; red[(F.wave * 2 + 1) * 64 + F.lane] = a1;
        __syncthreads();
        if (F.tid < 128) { const int b = F.tid >> 6, l = F.tid & 63; f32x4 s = {0.f, 0.f, 0.f, 0.f};
#pragma unroll
            for (int w = 0; w < 8; ++w) s += red[(w * 2 + b) * 64 + l];
            if (ks == 0) s += *(const f32x4*)(P.b_ada + cg * 256 + 4 * l);
            float* mp = mods + (size_t)b * NMOD + cg * 256 + 4 * l;
            atomicAdd(mp + 0, s[0]); atomicAdd(mp + 1, s[1]); atomicAdd(mp + 2, s[2]); atomicAdd(mp + 3, s[3]); }
        __syncthreads();
    }
}
__device__ __forceinline__ void phase_p0a(Frame& F, const Ptrs& P) {
    adaln_gemv<8, 0>(F, P);
    if (blockIdx.x == 1 % F.G && F.tid < 64) { float v = fabsf(P.qkg[F.tid] * P.qkg[64 + F.tid]);
#pragma unroll
        for (int o = 1; o < 64; o <<= 1) v = fmaxf(v, __shfl_xor(v, o));
        if (F.tid == 0) *(float*)(P.ws + WS_LB + 8192) = 8.0f * v; }
    if (blockIdx.x == 0) {
        float* lbp = (float*)(P.ws + WS_LB);
        for (int i = F.tid; i < 1024; i += 512) { const int d = i >> 9, c = i & 511; lbp[i] = 1.0f / (1.0f + expf(P.hlb[d * 1024 + 512 + c] - P.hlb[d * 1024 + c])); }
    }
}
__device__ __forceinline__ void phase_p0a_weights(Frame& F, const Ptrs& P, const int part, const int blk0) {
    LAS float* scr = (LAS float*)(F.lds + 16384 + F.wave * 12288);
    constexpr int I_1I = (D / 64) * (2 * FF / 32);
    const int NGW = F.G * NWAVES, split = NGW < I_1I ? NGW : I_1I;
    if (part == 0) { const int it = F.vcu * NWAVES + F.wave; if (it < split) p0_transpose_glu(P.w1i, (bf16*)(P.ws + WS_W1I), scr, it, F.lane); }
    else { const int b0 = blk0 < F.G ? blk0 : 0, nb = F.G - b0;
        if ((int)blockIdx.x >= b0) for (int it = split + ((int)blockIdx.x - b0) * NWAVES + F.wave; it < I_1I; it += nb * NWAVES) p0_transpose_glu(P.w1i, (bf16*)(P.ws + WS_W1I), scr, it, F.lane); }
}
__device__ __forceinline__ void deferred_weights(Frame& F, const Ptrs& P, int part, int widx, int nw) {
    const float* mods = (const float*)(P.ws + WS_MODS);
    const int set = part == 1 ? 2 : 1;
    LAS float* AB = (LAS float*)F.lds;
    for (int i = F.tid; i < 2048; i += 512) { const int b = i >> 10, col = i & 1023;
        const float sh = mods[b * NMOD + (3 * set) * D + col], sc = mods[b * NMOD + (3 * set + 1) * D + col];
        AB[(b * 2 + 0) * 1024 + col] = P.norm_g[set * D + col] * (1.0f + sc); AB[(b * 2 + 1) * 1024 + col] = sh; }
    __syncthreads();
    LAS float* scr = (LAS float*)(F.lds + 16384 + F.wave * 8704);
    const int gw = widx * NWAVES + F.wave, NGW = nw * NWAVES;
    constexpr int I_1O = (FF / 64) * (D / 32), I_MO = (D / 64) * (D / 32), I_MI = (D / 64) * (DIN / 32), I_2I = (D / 64) * (2 * FF / 32);
    if (part == 0) {
        for (int it = gw; it < I_1O + I_MI; it += NGW) {
            int r = it;
            if (r < I_1O) { p0_transpose_nat(P.w1o, FF, D, (bf16*)(P.ws + WS_W1O), scr, r, F.lane); continue; } r -= I_1O;
            const int nblk = DIN / 32, kb = r / nblk, nb = r % nblk;
            p0_transpose_mod(P.wmi, D, DIN, (bf16*)(P.ws + WS_WMI), (size_t)DIN * D, 64 * kb, 32 * nb, 32 * nb, scr, AB, (float*)(P.ws + WS_BMI), DIN, F.lane);
        }
    } else if (part == 1) {
        for (int it = gw; it < I_2I + I_MO + I_1O; it += NGW) {
            if (it >= I_2I + I_MO) { p0_transpose_nat(P.w2o, FF, D, (bf16*)(P.ws + WS_W2O), scr, it - I_2I - I_MO, F.lane); continue; }
            if (it >= I_2I) { p0_transpose_nat(P.wmo, D, D, (bf16*)(P.ws + WS_WMO), scr, it - I_2I, F.lane); continue; }
            const int nblk = (2 * FF) / 32, kb = it / nblk, nb = it % nblk, n0 = 32 * nb;
            p0_transpose_mod(P.w2i, D, 2 * FF, (bf16*)(P.ws + WS_W2I), (size_t)2 * FF * D, 64 * kb, n0, glu_row(n0), scr, AB, (float*)(P.ws + WS_B2I), 2 * FF, F.lane); }
    } else {
        for (int it = gw; it < I_1O; it += NGW) p0_transpose_nat(P.w2o, FF, D, (bf16*)(P.ws + WS_W2O), scr, it, F.lane);
    }
    __syncthreads();
}

__device__ __forceinline__ void phase_p0b(Frame& F, const Ptrs& P) {
    const float* mods = (const float*)(P.ws + WS_MODS);
    LAS float* AB = (LAS float*)F.lds;
    for (int i = F.tid; i < 2048; i += 512) { const int b = i >> 10, col = i & 1023;
        const float sh = mods[b * NMOD + col], sc = mods[b * NMOD + D + col];
        AB[(b * 2 + 0) * 1024 + col] = P.norm_g[col] * (1.0f + sc); AB[(b * 2 + 1) * 1024 + col] = sh; }
    __syncthreads();
    const int gw = F.vcu * NWAVES + F.wave, NGW = F.G * NWAVES;
    bf16* dst = (bf16*)(P.ws + WS_H);
    for (int m = gw; m < M; m += NGW) {
        const int b = m >= T;
        const GAS f32x4* xr = (const GAS f32x4*)(P.x + (size_t)m * D) + F.lane;
        f32x4 v[4]; float s = 0.f;
#pragma unroll
        for (int j = 0; j < 4; ++j) { v[j] = __builtin_nontemporal_load(xr + 64 * j); s += (v[j].x * v[j].x + v[j].y * v[j].y) + (v[j].z * v[j].z + v[j].w * v[j].w); }
        const float r = 1.0f / sqrtf(wave_sum(s) * (1.f / D) + EPS);
        GAS unsigned long long* o8 = (GAS unsigned long long*)(dst + (size_t)m * D) + F.lane;
#pragma unroll
        for (int j = 0; j < 4; ++j) { const f32x4 a = *(const LAS f32x4*)(AB + (b * 2 + 0) * 1024 + 256 * j + 4 * F.lane), sh = *(const LAS f32x4*)(AB + (b * 2 + 1) * 1024 + 256 * j + 4 * F.lane);
            const f32x4 o = v[j] * r * a + sh;
            o8[64 * j] = (unsigned long long)pk2(o.x, o.y) | ((unsigned long long)pk2(o.z, o.w) << 32); }
    }
    __syncthreads();
}

typedef float f32x16 __attribute__((ext_vector_type(16)));
typedef short v4i16_t __attribute__((ext_vector_type(4)));
typedef float f32x2_t __attribute__((ext_vector_type(2))); typedef __bf16 bf16x2_t __attribute__((ext_vector_type(2)));
__device__ __forceinline__ unsigned cvtpk_s(float lo, float hi) { f32x2_t v = {lo, hi}; bf16x2_t b = __builtin_convertvector(v, bf16x2_t); return __builtin_bit_cast(unsigned, b); }
__device__ __forceinline__ v4i16_t ds_tr16(LAS unsigned char* p) { return __builtin_amdgcn_ds_read_tr16_b64_v4i16((LAS v4i16_t*)p); }
__device__ __forceinline__ int crow16(int r, int hi) { return (r & 3) + 8 * (r >> 2) + 4 * hi; }
constexpr int AT_K = 0, AT_V = 49152, AT_T = 98304, AT_RK = 106496, AT_STG = 108544;

template <bool SPLIT, class Mid>
__device__ __forceinline__ void attn_phase(Frame& F, const Ptrs& P, const int xslot, Mid&& mid) {
    const bf16* Z = (const bf16*)(P.ws + WS_ZH); bf16* MIX = (bf16*)(P.ws + WS_MIX);
    LAS unsigned char* Kimg = F.lds + AT_K; LAS unsigned char* Vimg = F.lds + AT_V; LAS float* Tt = (LAS float*)(F.lds + AT_T); LAS float* rkT = (LAS float*)(F.lds + AT_RK);
    const int lane = F.lane, wave = F.wave, r32 = lane & 31, hi = lane >> 5, g = wave >> 1, qh = wave & 1;
    const float LOG2E = 1.4426950408889634f;
    const float shift = *(const float*)(P.ws + WS_LB + 8192);
    for (int item0 = F.vcu; item0 < 256; item0 += F.G) {
        int item = item0; if (xslot >= 0) { const int blk = 16 * (xslot >> 5) + ((xslot & 31) >> 1); item = (blk >> 6) * 128 + (xslot & 1) * 64 + (blk & 63); }
        const int b = item >> 7, kv = (item >> 6) & 1, n = item & 63, hq = 4 * kv + g;
        const bool edge = SPLIT && ((n & 15) == 0 || (n & 15) == 15);
        if (SPLIT && edge && item0 == F.vcu) mid(false);
        const int blk_lo = n == 0 ? 1 : 0, blk_hi = n == 63 ? 1 : 2;
        const long zrow0 = (long)b * T + 128 * (n - 1);
        for (int piece = wave; piece < 48; piece += 8) {
            const int blk = piece >> 4; if (blk < blk_lo || blk > blk_hi) continue;
            const int rr = lane >> 3, row = piece * 8 + rr, cK = (lane & 7) ^ rr, cV = (lane & 7) ^ (((rr >> 1) & 1) << 2);
            const bf16* rp = Z + (size_t)(zrow0 + row) * DIN;
            __builtin_amdgcn_global_load_lds((const unsigned*)(rp + ZC_AK + kv * 64 + cK * 8), (LAS unsigned*)(Kimg + piece * 1024), 16, 0, 0);
            __builtin_amdgcn_global_load_lds((const unsigned*)(rp + ZC_AV + kv * 64 + cV * 8), (LAS unsigned*)(Vimg + piece * 1024), 16, 0, 0);
        }
        if (SPLIT && !edge) {
#pragma unroll
            for (int sb = 0; sb < 2; ++sb) { const size_t m = (size_t)b * T + 128 * n + 64 * qh + 32 * sb + r32; const unsigned w_ = *(const unsigned*)(Z + m * DIN + ZC_AQ + hq * 64 + 8 * hi); asm volatile("" :: "v"(w_)); } }
        for (int idx = F.tid; idx < 4 * 512; idx += 512) { const int gg = idx >> 9, rel = (idx & 511) - 255, ar = rel < 0 ? -rel : rel;
            Tt[idx] = (ar <= 128) ? (P.relb[t5_bucket(rel) * 8 + 4 * kv + gg] - shift) * LOG2E : -30000.0f; }
        __syncthreads();
        if (F.tid < 384) { const int blk = F.tid >> 7; float rk = 0.f;
            if (blk >= blk_lo && blk <= blk_hi) { float ss = 0.f;
#pragma unroll
                for (int c = 0; c < 8; ++c) { const v4u w = *(const LAS v4u*)(Kimg + F.tid * 128 + c * 16);
                    const float a0 = bflo(w.x), a1 = bfhi(w.x), a2 = bflo(w.y), a3 = bfhi(w.y), a4 = bflo(w.z), a5 = bfhi(w.z), a6 = bflo(w.w), a7 = bfhi(w.w);
                    ss += (a0 * a0 + a1 * a1) + (a2 * a2 + a3 * a3) + (a4 * a4 + a5 * a5) + (a6 * a6 + a7 * a7); }
                rk = 1.0f / sqrtf(ss * (1.f / 64.f) + EPS); }
            rkT[F.tid] = rk; }
        __syncthreads();
        if (SPLIT && !edge && item0 == F.vcu) mid(true);
        bf16x8 qf[2][4];
        {
            float fac[4][8];
#pragma unroll
            for (int ks = 0; ks < 4; ++ks)
#pragma unroll
                for (int j = 0; j < 8; ++j) { const int d = 16 * ks + 8 * hi + j; fac[ks][j] = 0.125f * LOG2E * P.qkg[d] * P.qkg[64 + d]; }
#pragma unroll
            for (int sb = 0; sb < 2; ++sb) {
                const size_t m = (size_t)b * T + 128 * n + 64 * qh + 32 * sb + r32;
                const bf16* qp = Z + m * DIN + ZC_AQ + hq * 64 + 8 * hi;
                v4u raw[4]; float ss = 0.f;
#pragma unroll
                for (int ks = 0; ks < 4; ++ks) raw[ks] = *(const v4u*)(qp + 16 * ks);
#pragma unroll
                for (int ks = 0; ks < 4; ++ks) { const v4u w = raw[ks]; const float a0 = bflo(w.x), a1 = bfhi(w.x), a2 = bflo(w.y), a3 = bfhi(w.y), a4 = bflo(w.z), a5 = bfhi(w.z), a6 = bflo(w.w), a7 = bfhi(w.w);
                    ss += (a0 * a0 + a1 * a1) + (a2 * a2 + a3 * a3) + (a4 * a4 + a5 * a5) + (a6 * a6 + a7 * a7); }
                ss += __shfl_xor(ss, 32);
                const float rq = 1.0f / sqrtf(ss * (1.f / 64.f) + EPS);
#pragma unroll
                for (int ks = 0; ks < 4; ++ks) { const v4u w = raw[ks]; v4u o;
                    o.x = cvtpk_s(bflo(w.x) * rq * fac[ks][0], bfhi(w.x) * rq * fac[ks][1]); o.y = cvtpk_s(bflo(w.y) * rq * fac[ks][2], bfhi(w.y) * rq * fac[ks][3]);
                    o.z = cvtpk_s(bflo(w.z) * rq * fac[ks][4], bfhi(w.z) * rq * fac[ks][5]); o.w = cvtpk_s(bflo(w.w) * rq * fac[ks][6], bfhi(w.w) * rq * fac[ks][7]);
                    qf[sb][ks] = __builtin_bit_cast(bf16x8, o); }
            }
        }
        f32x16 O[2][2]; float lsum[2] = {0.f, 0.f};
#pragma unroll
        for (int sb = 0; sb < 2; ++sb)
#pragma unroll
            for (int db = 0; db < 2; ++db)
#pragma unroll
                for (int r = 0; r < 16; ++r) O[sb][db][r] = 0.f;
        int kt_lo = qh ? 2 : 0, kt_hi = qh ? 11 : 9;
        if (kt_lo < 4 * blk_lo) kt_lo = 4 * blk_lo;
        if (kt_hi > 4 * blk_hi + 3) kt_hi = 4 * blk_hi + 3;
        const int i16 = lane & 15, tq = i16 >> 2, tp = i16 & 3, tblk = (lane >> 4) & 1;
        for (int kt = kt_lo; kt <= kt_hi; ++kt) {
            const int key = 32 * kt + r32;
            bf16x8 kf[4];
#pragma unroll
            for (int ks = 0; ks < 4; ++ks) kf[ks] = *(const LAS bf16x8*)(Kimg + key * 128 + (((2 * ks + hi) ^ (key & 7)) << 4));
            f32x4 rkv[4];
#pragma unroll
            for (int g4 = 0; g4 < 4; ++g4) rkv[g4] = *(const LAS f32x4*)(rkT + 32 * kt + 8 * g4 + 4 * hi);
            bf16x8 vf[2][2];
#pragma unroll
            for (int db = 0; db < 2; ++db)
#pragma unroll
                for (int s = 0; s < 2; ++s) { const int k0 = 32 * kt + 16 * s + 4 * hi + tq, dbyte = (32 * db + 16 * tblk + 4 * tp) * 2;
                    const v4i16_t lo = ds_tr16(Vimg + k0 * 128 + (dbyte ^ (((k0 >> 1) & 1) << 6))), hh = ds_tr16(Vimg + (k0 + 8) * 128 + (dbyte ^ ((((k0 + 8) >> 1) & 1) << 6)));
                    vf[db][s] = (bf16x8){lo[0], lo[1], lo[2], lo[3], hh[0], hh[1], hh[2], hh[3]}; }
#pragma unroll
            for (int sb = 0; sb < 2; ++sb) {
                f32x16 S;
#pragma unroll
                for (int r = 0; r < 16; ++r) S[r] = 0.f;
#pragma unroll
                for (int ks = 0; ks < 4; ++ks) S = __builtin_amdgcn_mfma_f32_32x32x16_bf16(kf[ks], qf[sb][ks], S, 0, 0, 0);
                const LAS float* tb = Tt + g * 512 + (127 + 32 * kt - (64 * qh + 32 * sb + r32));
                float acc = 0.f;
#pragma unroll
                for (int r = 0; r < 16; ++r) { const float x = S[r] * rkv[r >> 2][r & 3] + tb[crow16(r, hi)]; S[r] = __builtin_amdgcn_exp2f(x); acc += S[r]; }
                lsum[sb] += acc;
                bf16x8 pf[2];
#pragma unroll
                for (int s = 0; s < 2; ++s) { v4u w; w.x = cvtpk_s(S[8 * s + 0], S[8 * s + 1]); w.y = cvtpk_s(S[8 * s + 2], S[8 * s + 3]); w.z = cvtpk_s(S[8 * s + 4], S[8 * s + 5]); w.w = cvtpk_s(S[8 * s + 6], S[8 * s + 7]);
                    pf[s] = __builtin_bit_cast(bf16x8, w); }
#pragma unroll
                for (int db = 0; db < 2; ++db)
#pragma unroll
                    for (int s = 0; s < 2; ++s) O[sb][db] = __builtin_amdgcn_mfma_f32_32x32x16_bf16(vf[db][s], pf[s], O[sb][db], 0, 0, 0);
            }
        }
        const float sinkp = __builtin_amdgcn_exp2f((P.sink[hq] - shift) * LOG2E);
        LAS unsigned char* stg = F.lds + AT_STG + wave * 2048;
#pragma unroll
        for (int sb = 0; sb < 2; ++sb) {
            const float l = lsum[sb] + __shfl_xor(lsum[sb], 32) + sinkp, il = 1.0f / l;
            const size_t m0 = (size_t)b * T + 128 * n + 64 * qh + 32 * sb;
#pragma unroll
            for (int db = 0; db < 2; ++db) {
#pragma unroll
                for (int g4 = 0; g4 < 4; ++g4) { const unsigned lo = cvtpk_s(O[sb][db][4 * g4] * il, O[sb][db][4 * g4 + 1] * il), hh = cvtpk_s(O[sb][db][4 * g4 + 2] * il, O[sb][db][4 * g4 + 3] * il);
                    *(LAS unsigned long long*)(stg + r32 * 64 + ((g4 ^ ((r32 >> 1) & 3)) << 4) + 8 * hi) = (unsigned long long)lo | ((unsigned long long)hh << 32); }
                asm volatile("s_waitcnt lgkmcnt(0)" ::: "memory");
#pragma unroll
                for (int k2 = 0; k2 < 2; ++k2) { const int row = 16 * k2 + (lane >> 2), ch = lane & 3;
                    const v4u w = *(const LAS v4u*)(stg + row * 64 + ((ch ^ ((row >> 1) & 3)) << 4));
                    *(v4u*)(MIX + (m0 + row) * D + 512 + hq * 64 + 32 * db + 8 * ch) = w; }
                asm volatile("s_waitcnt lgkmcnt(0)" ::: "memory");
            }
        }
        __syncthreads();
    }
}

typedef float f32x2v __attribute__((ext_vector_type(2)));
constexpr int HG_Q = 0, HG_G = 16384, HG_V = 32768, HG_QT = 65536, HG_KT = 81920, HG_KD = 98304, HG_A = 114688;
#define MFMA16(a, b, c) __builtin_amdgcn_mfma_f32_16x16x32_bf16((a), (b), (c), 0, 0, 0)
__device__ __forceinline__ bf16x8 tr_pair(LAS unsigned char* lo, LAS unsigned char* hh) { const v4i16_t a = ds_tr16(lo), b = ds_tr16(hh); return (bf16x8){a[0], a[1], a[2], a[3], b[0], b[1], b[2], b[3]}; }
__device__ __forceinline__ bf16x8 pack8(f32x4 a, f32x4 b) { v4u w; w.x = cvtpk_s(a[0], a[1]); w.y = cvtpk_s(a[2], a[3]); w.z = cvtpk_s(b[0], b[1]); w.w = cvtpk_s(b[2], b[3]); return __builtin_bit_cast(bf16x8, w); }

__device__ __forceinline__ void glds16(const void* gsrc, unsigned lds_dst) { unsigned keep;
    asm volatile("s_mov_b32 %0, m0\n\ts_mov_b32 m0, %2\n\ts_nop 0\n\tglobal_load_lds_dwordx4 %1, off\n\ts_mov_b32 m0, %0" : "=&s"(keep) : "v"(gsrc), "s"(lds_dst) : "memory"); }
#define HG_SW(r) ((((r) & 15) ^ ((((r) >> 4) & 3) << 1)) << 4)
#define HG_BAR_L() do { asm volatile("s_waitcnt lgkmcnt(0)" ::: "memory"); __builtin_amdgcn_s_barrier(); asm volatile("" ::: "memory"); } while (0)
#define HG_BAR_VL() do { asm volatile("s_waitcnt vmcnt(0) lgkmcnt(0)" ::: "memory"); __builtin_amdgcn_s_barrier(); asm volatile("" ::: "memory"); } while (0)
#define HG_BAR_V16L() do { asm volatile("s_waitcnt vmcnt(16) lgkmcnt(0)" ::: "memory"); __builtin_amdgcn_s_barrier(); asm volatile("" ::: "memory"); } while (0)
constexpr int HP_Q = 0, HP_G = 16384, HP_V = 32768, HP_IMG = 65536  , HP_A = 131072, HP_TOT = 139264  , HP_TAB = 141312  ;
static_assert(HP_TAB + 2 * 1536 <= RING_BYTES, "pass-1 LDS map");
__device__ __forceinline__ void hgrn_pass1(Frame& F, const Ptrs& P, const int xslot) {
    bf16* Z = (bf16*)(P.ws + WS_ZH); bf16* OL = (bf16*)P.out; float* SLOC = (float*)(P.ws + WS_SLOC); float* DSEG = (float*)(P.ws + WS_DSEG);
    LAS unsigned char* L = F.lds;
    const unsigned lds0 = (unsigned)(uintptr_t)(unsigned char*)F.lds;
    const int lane = F.lane, wave = F.wave;
    const bool isM = wave < 4; const int mw = wave & 3;
    const float LOG2E = 1.4426950408889634f;
    for (int item0 = F.vcu; item0 < 256; item0 += F.G) {
        int item = item0; if (xslot >= 0) { const int x_ = xslot >> 5, r_ = xslot & 31, d_ = (r_ >> 2) & 1, tb_ = 4 * (x_ & 3) + (r_ >> 3); item = ((((x_ >> 2) * 4 + (r_ & 3)) * 2 + d_) << 4) + (d_ ? 15 - tb_ : tb_); }
        const int chain = item >> 4, p = item & 15, dir = chain & 1, h = (chain >> 1) & 3, b = chain >> 3;
        const int qcol = ZC_Q + h * 128, gcol = (dir ? ZC_GB : ZC_GF) + h * 128, vcol = ZC_V + h * 128;
        const int tok0 = dir ? (512 * (15 - p) + 511) : 512 * p, tstep = dir ? -1 : 1;
        const size_t rowb = (size_t)b * T;
        if (!isM) {
            float goff0 = 0.f, goff1 = 0.f;
            f32x2v qv[16], gl[16];
#define HP_DMA_QG(c) do { _Pragma("unroll") for (int k_ = 0; k_ < 8; ++k_) { const int tile = k_ >> 2, pp = 4 * mw + (k_ & 3), row = 4 * pp + (lane >> 4); \
                const int csrc = (lane & 15) ^ (HG_SW(row) >> 4); \
                const bf16* src = Z + (rowb + tok0 + tstep * (64 * (c) + row)) * DIN + (tile ? gcol : qcol) + 8 * csrc; \
                glds16(src, (unsigned)__builtin_amdgcn_readfirstlane(lds0 + (tile ? HP_G : HP_Q) + pp * 1024)); } } while (0)
#define HP_DMA_V(c) do { _Pragma("unroll") for (int k_ = 0; k_ < 4; ++k_) { const int pp = 4 * mw + k_, row = 4 * pp + (lane >> 4); \
                const int csrc = (lane & 15) ^ (HG_SW(row) >> 4); \
                const bf16* src = Z + (rowb + tok0 + tstep * (64 * (c) + row)) * DIN + vcol + 8 * csrc; \
                glds16(src, (unsigned)__builtin_amdgcn_readfirstlane(lds0 + HP_V + ((c) & 1) * 16384 + pp * 1024)); } } while (0)
#define HP_EW1(cc) do { f32x2v run = {0.f, 0.f}; \
                _Pragma("unroll") for (int u = 0; u < 16; ++u) { const int r = 16 * mw + u, off = r * 256 + ((lane * 4) ^ HG_SW(r)); const unsigned wq = *(const LAS unsigned*)(L + HP_Q + off), wg = *(const LAS unsigned*)(L + HP_G + off); \
                    qv[u] = (f32x2v){bflo(wq), bfhi(wq)}; run = run + (f32x2v){bflo(wg), bfhi(wg)} * LOG2E; gl[u] = run; } \
                *(LAS f32x2v*)(L + HP_TOT + (mw * 128 + 2 * lane) * 4) = run; } while (0)
#define HP_EW2(cc) do { f32x2v base = {0.f, 0.f}, gmid = {0.f, 0.f}, glast = {0.f, 0.f}; \
                _Pragma("unroll") for (int w2 = 0; w2 < 4; ++w2) { const f32x2v tv = *(const LAS f32x2v*)(L + HP_TOT + (w2 * 128 + 2 * lane) * 4); \
                    if (w2 < mw) base = base + tv; if (w2 < 2) gmid = gmid + tv; glast = glast + tv; } \
                const f32x2v c2_ = gmid + (f32x2v){goff0, goff1}; const f32x2v sgv = {__builtin_amdgcn_exp2f(c2_.x), __builtin_amdgcn_exp2f(c2_.y)}; \
                const f32x2v bmg = base - gmid; LAS unsigned char* img = L + HP_IMG + ((cc) & 1) * 32768; \
                _Pragma("unroll") for (int u = 0; u < 16; ++u) { const int r = 16 * mw + u; \
                    f32x2v x = bmg + gl[u]; x.x = fminf(fmaxf(x.x, -115.f), 115.f); x.y = fminf(fmaxf(x.y, -115.f), 115.f); \
                    const f32x2v E = {__builtin_amdgcn_exp2f(x.x), __builtin_amdgcn_exp2f(x.y)}, I = {__builtin_amdgcn_rcpf(E.x), __builtin_amdgcn_rcpf(E.y)}; \
                    const f32x2v g2 = u ? gl[u] - gl[u - 1] : gl[u]; \
                    const f32x2v k = 1.0f - (f32x2v){__builtin_amdgcn_exp2f(g2.x), __builtin_amdgcn_exp2f(g2.y)}; \
                    const f32x2v Q = qv[u] * E, K = k * I, QS = Q * sgv; \
                    const int off = r * 256 + ((lane * 4) ^ HG_SW(r)); \
                    *(LAS unsigned*)(img + off) = cvtpk_s(Q.x, Q.y); *(LAS unsigned*)(img + 16384 + off) = cvtpk_s(K.x, K.y); \
                    *(unsigned*)(Z + (rowb + tok0 + tstep * (64 * (cc) + r)) * DIN + gcol + 2 * lane) = cvtpk_s(QS.x, QS.y); } \
                if (mw == 0) { LAS unsigned char* tb = L + HP_TAB + ((cc) & 1) * 1536; const f32x2v dlt = glast - gmid; \
                    *(LAS f32x2v*)(tb + 8 * lane) = (f32x2v){__builtin_amdgcn_exp2f(glast.x), __builtin_amdgcn_exp2f(glast.y)}; \
                    *(LAS f32x2v*)(tb + 512 + 8 * lane) = (f32x2v){__builtin_amdgcn_exp2f(gmid.x), __builtin_amdgcn_exp2f(gmid.y)}; \
                    *(LAS f32x2v*)(tb + 1024 + 8 * lane) = (f32x2v){__builtin_amdgcn_exp2f(dlt.x), __builtin_amdgcn_exp2f(dlt.y)}; } \
                goff0 += glast.x; goff1 += glast.y; } while (0)
            HP_DMA_QG(0); HP_DMA_V(0);
            HG_BAR_VL();
            HP_EW1(0); HP_DMA_QG(1); HP_DMA_V(1);
            HG_BAR_L();
            HP_EW2(0);
            HG_BAR_V16L();
            for (int c = 0; c < 8; ++c) {
                if (c + 1 < 8) { HP_EW1(c + 1); if (c + 2 < 8) HP_DMA_QG(c + 2); }
                HG_BAR_L();
                if (c + 2 < 8) HP_DMA_V(c + 2);
                if (c + 1 < 8) HP_EW2(c + 1);
                HG_BAR_V16L();
            }
            if (mw == 0) *(f32x2v*)(DSEG + item * 128 + 2 * lane) = (f32x2v){__builtin_amdgcn_exp2f(goff0), __builtin_amdgcn_exp2f(goff1)};
#undef HP_DMA_QG
#undef HP_DMA_V
#undef HP_EW1
#undef HP_EW2
        } else {
            f32x4 S[8][2];
#pragma unroll
            for (int db = 0; db < 8; ++db) { S[db][0] = (f32x4){0.f, 0.f, 0.f, 0.f}; S[db][1] = (f32x4){0.f, 0.f, 0.f, 0.f}; }
            HG_BAR_VL(); HG_BAR_L(); HG_BAR_VL();
            for (int c = 0; c < 8; ++c) {
                int l15 = lane & 15, g = lane >> 4; asm volatile("" : "+v"(l15), "+v"(g));
                const int tq = l15 >> 2, tp = l15 & 3;
                LAS unsigned char* QT = L + HP_IMG + (c & 1) * 32768; LAS unsigned char* KT = QT + 16384; LAS unsigned char* Vc = L + HP_V + (c & 1) * 16384; LAS unsigned char* tb = L + HP_TAB + (c & 1) * 1536;
                { const int rowq = 16 * mw + l15; bf16x8 qf[4], kf[4][4];
#pragma unroll
                  for (int kk = 0; kk < 4; ++kk) { qf[kk] = *(const LAS bf16x8*)(QT + rowq * 256 + (((4 * kk + g) << 4) ^ HG_SW(rowq)));
#pragma unroll
                      for (int j = 0; j < 4; ++j) { const int rowk = 16 * j + l15; kf[j][kk] = *(const LAS bf16x8*)(KT + rowk * 256 + (((4 * kk + g) << 4) ^ HG_SW(rowk))); } }
                  __builtin_amdgcn_sched_barrier(0);
#pragma unroll
                  for (int j = 0; j < 4; ++j) { f32x4 C = {0.f, 0.f, 0.f, 0.f};
#pragma unroll
                      for (int kk = 0; kk < 4; ++kk) C = MFMA16(kf[j][kk], qf[kk], C);
                      const int s0 = 16 * j + 4 * g, t = rowq;
                      const unsigned lo = cvtpk_s(s0 + 0 <= t ? C[0] : 0.f, s0 + 1 <= t ? C[1] : 0.f), hh = cvtpk_s(s0 + 2 <= t ? C[2] : 0.f, s0 + 3 <= t ? C[3] : 0.f);
                      *(LAS unsigned long long*)(L + HP_A + t * 128 + (((2 * j + (g >> 1)) ^ (t & 7)) << 4) + 8 * (g & 1)) = (unsigned long long)lo | ((unsigned long long)hh << 32); } }
                f32x4 oT[4][2];
#pragma unroll
                for (int ti = 0; ti < 4; ++ti) { oT[ti][0] = (f32x4){0.f, 0.f, 0.f, 0.f}; oT[ti][1] = (f32x4){0.f, 0.f, 0.f, 0.f}; }
                { f32x4 m0[4], m1[4]; unsigned long long q0[4][4], q1[4][4];
#pragma unroll
                  for (int kk = 0; kk < 4; ++kk) { m0[kk] = *(const LAS f32x4*)(tb + 512 + (32 * kk + 4 * g) * 4); m1[kk] = *(const LAS f32x4*)(tb + 512 + (32 * kk + 16 + 4 * g) * 4);
#pragma unroll
                      for (int ti = 0; ti < 4; ++ti) { const int t = 16 * ti + l15, db0 = 64 * kk + 8 * g;
                          q0[kk][ti] = *(const LAS unsigned long long*)(QT + t * 256 + (db0 ^ HG_SW(t))); q1[kk][ti] = *(const LAS unsigned long long*)(QT + t * 256 + ((db0 + 32) ^ HG_SW(t))); } }
                  __builtin_amdgcn_sched_barrier(0);
#pragma unroll
                  for (int kk = 0; kk < 4; ++kk) {
                      const bf16x8 sf0 = pack8(S[2 * kk][0] * m0[kk], S[2 * kk + 1][0] * m1[kk]), sf1 = pack8(S[2 * kk][1] * m0[kk], S[2 * kk + 1][1] * m1[kk]);
#pragma unroll
                      for (int ti = 0; ti < 4; ++ti) { v4u w; w.x = (unsigned)q0[kk][ti]; w.y = (unsigned)(q0[kk][ti] >> 32); w.z = (unsigned)q1[kk][ti]; w.w = (unsigned)(q1[kk][ti] >> 32); const bf16x8 qb = __builtin_bit_cast(bf16x8, w);
                          oT[ti][0] = MFMA16(sf0, qb, oT[ti][0]); oT[ti][1] = MFMA16(sf1, qb, oT[ti][1]); } } }
                bf16x8 vf[2][2];
#pragma unroll
                for (int kk = 0; kk < 2; ++kk)
#pragma unroll
                    for (int es = 0; es < 2; ++es) { const int s = 32 * kk + 8 * g + tq, cb = 64 * mw + 32 * es + 8 * tp;
                        vf[kk][es] = tr_pair(Vc + s * 256 + (cb ^ HG_SW(s)), Vc + (s + 4) * 256 + (cb ^ HG_SW(s + 4))); }
#pragma unroll
                for (int dg = 0; dg < 2; ++dg) { f32x4 ta[4], tbv[4]; bf16x8 kd[4][2];
#pragma unroll
                    for (int d4 = 0; d4 < 4; ++d4) { const int db = 4 * dg + d4; ta[d4] = *(const LAS f32x4*)(tb + (16 * db + 4 * g) * 4); tbv[d4] = *(const LAS f32x4*)(tb + 1024 + (16 * db + 4 * g) * 4);
#pragma unroll
                        for (int kk = 0; kk < 2; ++kk) { const int s = 32 * kk + 8 * g + tq, cb = 32 * db + 8 * tp;
                            kd[d4][kk] = tr_pair(KT + s * 256 + (cb ^ HG_SW(s)), KT + (s + 4) * 256 + (cb ^ HG_SW(s + 4))); } }
                    __builtin_amdgcn_sched_barrier(0);
#pragma unroll
                    for (int d4 = 0; d4 < 4; ++d4) { const int db = 4 * dg + d4;
#pragma unroll
                        for (int es = 0; es < 2; ++es) { f32x4 kv = {0.f, 0.f, 0.f, 0.f}; kv = MFMA16(kd[d4][0], vf[0][es], kv); kv = MFMA16(kd[d4][1], vf[1][es], kv);
                            S[db][es] = S[db][es] * ta[d4] + kv * tbv[d4]; } } }
                HG_BAR_L();
#pragma unroll
                for (int ti = 0; ti < 4; ++ti)
#pragma unroll
                    for (int kk = 0; kk < 2; ++kk) { if (kk == 1 && ti < 2) continue; const int t = 16 * ti + l15;
                        const bf16x8 af = *(const LAS bf16x8*)(L + HP_A + t * 128 + (((4 * kk + g) ^ (t & 7)) << 4));
                        oT[ti][0] = MFMA16(vf[kk][0], af, oT[ti][0]); oT[ti][1] = MFMA16(vf[kk][1], af, oT[ti][1]); }
#pragma unroll
                for (int ti = 0; ti < 4; ++ti)
#pragma unroll
                    for (int es = 0; es < 2; ++es) { const int r = 16 * ti + l15;
                        const size_t tk = (size_t)dir * M + rowb + tok0 + tstep * (64 * c + r);
                        *(unsigned long long*)(OL + ((tk >> 4) * 4 + h) * 2048 + (8 * mw + 4 * es + g) * 64 + (tk & 15) * 4) =
                            (unsigned long long)cvtpk_s(oT[ti][es][0], oT[ti][es][1]) | ((unsigned long long)cvtpk_s(oT[ti][es][2], oT[ti][es][3]) << 32); }
                HG_BAR_L();
            }
            { const int l15 = lane & 15, g = lane >> 4;
#pragma unroll
              for (int db = 0; db < 8; ++db)
#pragma unroll
                  for (int es = 0; es < 2; ++es) { const f32x4 sv = S[db][es];
                      *(unsigned long long*)((bf16*)SLOC + (size_t)item * 16384 + (32 * mw + 16 * es + l15) * 128 + 16 * db + 4 * g) = (unsigned long long)cvtpk_s(sv[0], sv[1]) | ((unsigned long long)cvtpk_s(sv[2], sv[3]) << 32); } }
        }
        HG_BAR_VL();
    }
}

__device__ __forceinline__ void hgrn_pass2(Frame& F, const Ptrs& P, const int widx, const int nw) {
    const float* SLOC = (const float*)(P.ws + WS_SLOC); const float* DSEG = (const float*)(P.ws + WS_DSEG); bf16* SIN = (bf16*)(P.ws + WS_SIN);
    for (int gid0 = widx * 512 + F.tid; gid0 < 16 * 8192; gid0 += 2 * nw * 512) {
        const int gid1 = gid0 + nw * 512; const bool two = gid1 < 16 * 8192;
        unsigned xs[2][16]; f32x2v ds[2][16];
#pragma unroll
        for (int q = 0; q < 2; ++q) { const int gid = (q && two) ? gid1 : gid0;
            const int chain = gid >> 13, flat = 2 * (gid & 8191), d = flat & 127;
#pragma unroll
            for (int p = 0; p < 16; ++p) { const size_t item = (size_t)chain * 16 + p; xs[q][p] = *(const unsigned*)((const bf16*)SLOC + item * 16384 + flat); ds[q][p] = *(const f32x2v*)(DSEG + item * 128 + d); } }
#pragma unroll
        for (int q = 0; q < 2; ++q) { const int gid = q ? gid1 : gid0; const bool on = q == 0 || two;
            const int chain = gid >> 13, flat = 2 * (gid & 8191);
            float s0 = 0.f, s1 = 0.f;
#pragma unroll
            for (int p = 0; p < 16; ++p) { const size_t item = (size_t)chain * 16 + p;
                if (on) *(unsigned*)(SIN + item * 16384 + flat) = cvtpk_s(s0, s1);
                s0 = ds[q][p].x * s0 + bflo(xs[q][p]); s1 = ds[q][p].y * s1 + bfhi(xs[q][p]); } }
    }
}

__device__ __forceinline__ void hgrn_pass3(Frame& F, const Ptrs& P, const int xslot) {
    const bf16* Z = (const bf16*)(P.ws + WS_ZH); const bf16* OL = (const bf16*)P.out; const bf16* SIN = (const bf16*)(P.ws + WS_SIN); bf16* MIX = (bf16*)(P.ws + WS_MIX);
    LAS unsigned char* L = F.lds;
    const int lane = F.lane, wave = F.wave, l15 = lane & 15, g = lane >> 4;
    for (int it0 = F.vcu; it0 < 256; it0 += F.G) {
        int it = it0; if (xslot >= 0) { const int panel = 8 * (xslot >> 5) + ((xslot & 31) >> 2); it = (panel >> 5) * 128 + (xslot & 3) * 32 + (panel & 31); }
        const int hf = it & 1, ns = (it >> 1) & 15, h = (it >> 5) & 3, b = it >> 7;
        const int itemf = ((b * 4 + h) * 2 + 0) * 16 + ns, itemb = ((b * 4 + h) * 2 + 1) * 16 + (15 - ns);
#pragma unroll
        for (int k_ = 0; k_ < 8; ++k_) { const int piece = wave + 8 * k_, dr = piece >> 5, pp = piece & 31, e = 4 * pp + (lane >> 4), cs = (lane & 15) ^ (e & 15);
            const bf16* src = SIN + (size_t)(dr ? itemb : itemf) * 16384 + e * 128 + 8 * cs;
            __builtin_amdgcn_global_load_lds((const unsigned*)src, (LAS unsigned*)(L + dr * 32768 + pp * 1024), 16, 0, 0); }
        const size_t tokw = (size_t)b * T + 512 * ns + 256 * hf + 32 * wave;
        LAS unsigned char* stg = L + 65536 + wave * 4096;
        __syncthreads();
#pragma unroll 1
        for (int tt = 0; tt < 2; ++tt) {
            const size_t tok = tokw + 16 * tt + l15;
            f32x4 acc[8];
#pragma unroll
            for (int et = 0; et < 8; ++et) acc[et] = (f32x4){0.f, 0.f, 0.f, 0.f};
#pragma unroll 1
            for (int dr = 0; dr < 2; ++dr) {
                const bf16* qp = Z + tok * DIN + (dr ? ZC_GB : ZC_GF) + h * 128 + 8 * g;
                bf16x8 qf[4];
#pragma unroll
                for (int kk = 0; kk < 4; ++kk) qf[kk] = *(const bf16x8*)(qp + 32 * kk);
                LAS unsigned char* sb = L + dr * 32768 + l15 * 256;
#pragma unroll
                for (int kk = 0; kk < 4; ++kk) { LAS unsigned char* sk = sb + (((4 * kk + g) ^ l15) << 4);
                    bf16x8 sf[8];
#pragma unroll
                    for (int et = 0; et < 8; ++et) sf[et] = *(const LAS bf16x8*)(sk + et * 4096);
#pragma unroll
                    for (int et = 0; et < 8; ++et) acc[et] = MFMA16(sf[et], qf[kk], acc[et]); }
            }
            const bf16* olf = OL + ((tok >> 4) * 4 + h) * 2048 + g * 64 + l15 * 4; const bf16* olb = olf + (size_t)M * 512;
            float ss = 0.f;
#pragma unroll
            for (int et = 0; et < 8; ++et) {
                const unsigned long long a = *(const unsigned long long*)(olf + 256 * et), c2 = *(const unsigned long long*)(olb + 256 * et);
                f32x4 o = acc[et];
                o[0] += bflo((unsigned)a) + bflo((unsigned)c2); o[1] += bfhi((unsigned)a) + bfhi((unsigned)c2);
                o[2] += bflo((unsigned)(a >> 32)) + bflo((unsigned)(c2 >> 32)); o[3] += bfhi((unsigned)(a >> 32)) + bfhi((unsigned)(c2 >> 32));
                acc[et] = o; ss += (o[0] * o[0] + o[1] * o[1]) + (o[2] * o[2] + o[3] * o[3]); }
            ss += __shfl_xor(ss, 16); ss += __shfl_xor(ss, 32);
            const float r = 1.0f / sqrtf(ss * (1.f / 128.f) + EPS);
            const bf16* gtp = Z + tok * DIN + ZC_GATE + h * 128 + 4 * g; const float* ngp = P.hng + h * 128 + 4 * g;
#pragma unroll
            for (int et = 0; et < 8; ++et) {
                const unsigned long long gt = *(const unsigned long long*)(gtp + 16 * et); const f32x4 ng = *(const f32x4*)(ngp + 16 * et); const f32x4 o = acc[et];
                const unsigned lo = cvtpk_s(o[0] * r * ng[0] * bflo((unsigned)gt), o[1] * r * ng[1] * bfhi((unsigned)gt)), hh = cvtpk_s(o[2] * r * ng[2] * bflo((unsigned)(gt >> 32)), o[3] * r * ng[3] * bfhi((unsigned)(gt >> 32)));
                *(LAS unsigned long long*)(stg + l15 * 256 + (((2 * et + (g >> 1)) ^ l15) << 4) + 8 * (g & 1)) = (unsigned long long)lo | ((unsigned long long)hh << 32); }
            asm volatile("s_waitcnt lgkmcnt(0)" ::: "memory");
#pragma unroll
            for (int k4 = 0; k4 < 4; ++k4) { const int row = 4 * k4 + (lane >> 4), ch = lane & 15;
                const v4u w = *(const LAS v4u*)(stg + row * 256 + ((ch ^ row) << 4));
                *(v4u*)(MIX + (tokw + 16 * tt + row) * D + h * 128 + 8 * ch) = w; }
            asm volatile("s_waitcnt lgkmcnt(0)" ::: "memory");
        }
        __syncthreads();
    }
}

__device__ __forceinline__ void refresh_frame(Frame& F) { int t = threadIdx.x; asm volatile("" : "+v"(t)); F.tid = t; F.lane = t & 63; }
struct Args { Ptrs p; int ph_lo, ph_hi, li, pad; };
__global__ void __launch_bounds__(NWAVES * 64, 2) mk_fwd(Args args) {
    extern __shared__ __attribute__((aligned(16))) unsigned char lds[];
    Frame F;
    F.lds = (LAS unsigned char*)lds;
    F.MISC = (volatile LAS unsigned*)(F.lds + MISC_OFF);
    F.tid = threadIdx.x; F.lane = F.tid & 63; F.wave = __builtin_amdgcn_readfirstlane(F.tid >> 6);
    F.G = gridDim.x; { const int bx = blockIdx.x; F.vcu = (F.G % 8 == 0) ? (bx % 8) * (F.G / 8) + bx / 8 : bx; }
    const Ptrs& P = args.p;
    F.ctl = (gu32*)(P.ws + WS_CTL);
    for (int u = F.tid; u < (LDS_BYTES - LDSCTL_OFF) / 4; u += NWAVES * 64) ((LAS unsigned*)(F.lds + LDSCTL_OFF))[u] = 0u;
    __syncthreads();
    XcdBarrier bar; bar.bar = (unsigned*)(F.ctl + CW_BAR); bar.x = 0; bar.st = nullptr;
    if (N_LAUNCHES != PER_PHASE) bar = xcd_barrier_post((unsigned*)(F.ctl + CW_BAR), F.MISC + 8);
#define GRID_BAR() do { if (N_LAUNCHES != PER_PHASE) xcd_barrier(bar); } while (0)
#define LOCAL_OK() (N_LAUNCHES != PER_PHASE && F.G == 256 && F.MISC[8 + 5] == 1u)
#define XSLOT() (LOCAL_OK() ? (int)(bar.x * 32u + F.MISC[8 + 4]) : -1)
#define GEMM_C() (LOCAL_OK() ? (int)(F.MISC[8 + 4] * 8u + bar.x) : (int)blockIdx.x)
#define LOCAL_BAR() do { if (N_LAUNCHES != PER_PHASE) { if (LOCAL_OK()) xcd_local_barrier(bar); else xcd_barrier(bar); } } while (0)
    const int lo = args.ph_lo, hi = args.ph_hi;
#define IN(k) (refresh_frame(F), lo <= (k) && (k) < hi)
#define BOTH(k) (IN(k) && IN((k) + 1))
    bf16* const Hb = (bf16*)(P.ws + WS_H); bf16* const ZH = (bf16*)(P.ws + WS_ZH); bf16* const MIXb = (bf16*)(P.ws + WS_MIX);
    const float* const mods = (const float*)(P.ws + WS_MODS);

    bf16* const Xb = (bf16*)(P.ws + WS_X);
    float* const SS1 = (float*)(P.ws + WS_SS1); float* const SS2 = (float*)(P.ws + WS_SS2);
    if (IN(0)) { phase_p0a(F, P); if (BOTH(0) && N_LAUNCHES != PER_PHASE) xcd_barrier_arrive(bar); phase_p0a_weights(F, P, 0, 0); if (BOTH(0) && N_LAUNCHES != PER_PHASE) xcd_barrier_wait(bar); }
    if (IN(1)) { phase_p0b(F, P); if (BOTH(1) && N_LAUNCHES != PER_PHASE) { xcd_barrier_arrive(bar); adaln_gemv<16, 1>(F, P); phase_p0a_weights(F, P, 1, 96); xcd_barrier_wait(bar); } else { adaln_gemv<16, 1>(F, P); phase_p0a_weights(F, P, 1, 96); } }
    if (IN(2)) { const int gc = GEMM_C();
        pg8::Gemm g{Hb, (const bf16*)(P.ws + WS_W1I), M, 2 * FF, D, 0}; pg8::StaticOrder S; S.init(M, 2 * FF, F.G, gc, WG_IN);
        pg8::EpiSwiGLU<false> E{ZH, FF, nullptr, 0, {}};
        pg8::gemm_phase<pg8::EpiSwiGLU<false>, pg8::StaticOrder, PG8_ALIGN, PG8_SP2>(F.lds + RING_OFF, g, S, E);
        { const int nfull = (M / 256) * (2 * FF / 256) % F.G;
          if (nfull == 0) deferred_weights(F, P, 0, gc, F.G); else if (gc >= nfull) deferred_weights(F, P, 0, gc - nfull, F.G - nfull); }
        if (BOTH(2) && N_LAUNCHES != PER_PHASE) { xcd_barrier_arrive(bar); adaln_gemv<4, 2>(F, P); xcd_barrier_wait(bar); } else adaln_gemv<4, 2>(F, P);
    }
    if (IN(3)) { const int gc = GEMM_C();
        pg8::Gemm g{ZH, (const bf16*)(P.ws + WS_W1O), M, D, FF, 0}; pg8::StaticOrder S; S.init(M, D, F.G, gc, WG_OUT);
        pg8::EpiResid<0> E{P.x, nullptr, Xb, nullptr, mods + 2 * D, NMOD, 0.5f, SS1};
        pg8::gemm_phase<pg8::EpiResid<0>, pg8::StaticOrder, PG8_ALIGN, PG8_SP2>(F.lds + RING_OFF, g, S, E);
        if (BOTH(3)) LOCAL_BAR();
    }
    if (IN(4)) { const int gc = GEMM_C();
        pg8::Gemm g{Xb, (const bf16*)(P.ws + WS_WMI), M, DIN, D, (size_t)DIN * D * 2}; pg8::StaticOrder S; S.init(M, DIN, F.G, gc, WG_IN, (28 << 8) | (20 << 16) | (8 << 24));
        pg8::EpiMixIn E{ZH, (LAS float*)(F.lds + pg8::EPT_OFF), 0, {}};
        { const float* lb = (const float*)(P.ws + WS_LB); const float* bmi = (const float*)(P.ws + WS_BMI); const int h = F.tid >> 8, e = F.tid & 255;
#pragma unroll
          for (int k = 0; k < 6; ++k) { const int p = 2 * k + h, i = p / 3, a = p % 3; pg8::Unit u; float v = 1.0f;
              if (S.next(i, u)) { if (a == 0) v = SS1[u.pm * 256 + e]; else if (a == 1) v = bmi[(u.pm >= 32 ? DIN : 0) + u.pn * 256 + e]; else if (u.pn >= 2 && u.pn < 6) v = lb[u.pn * 256 + e - 512]; }
              E.tv.v[k] = v; }
          int nu = 0; { pg8::Unit u; while (nu < 4 && S.next(nu, u)) ++nu; } E.npairs = 3 * nu; }
        pg8::gemm_phase<pg8::EpiMixIn, pg8::StaticOrder, PG8_ALIGN, PG8_SP2>(F.lds + RING_OFF, g, S, E);
        { const int nfull = (M / 256) * (DIN / 256) % F.G, cl = S.slot((M / 256) * (DIN / 256) / F.G);
          if (nfull == 0) deferred_weights(F, P, 1, gc, F.G); else if (cl >= nfull) deferred_weights(F, P, 1, cl - nfull, F.G - nfull); }
        if (BOTH(4)) LOCAL_BAR();
    }
    if (IN(5)) { hgrn_pass1(F, P, XSLOT()); if (BOTH(5) && N_LAUNCHES != PER_PHASE) { if (LOCAL_OK()) xcd_barrier_arrive(bar); else xcd_barrier(bar); } }
    if (IN(6)) {
        if (LOCAL_OK()) { const int xs_ = XSLOT(), r_ = xs_ & 31;
            attn_phase<true>(F, P, xs_, [&](bool do_p2) { xcd_barrier_wait(bar); if (do_p2) hgrn_pass2(F, P, (xs_ >> 5) * 28 + (r_ - 2), 224); xcd_barrier_arrive(bar); }); }
        else { hgrn_pass2(F, P, (int)blockIdx.x, F.G); if (BOTH(6) && N_LAUNCHES != PER_PHASE) xcd_barrier_arrive(bar); attn_phase<false>(F, P, -1, [](bool) {}); }
        if (BOTH(6) && N_LAUNCHES != PER_PHASE) xcd_barrier_wait(bar); }
    if (IN(7)) { hgrn_pass3(F, P, XSLOT()); if (BOTH(7)) LOCAL_BAR(); }
    if (IN(8)) { const int gc = GEMM_C();
        pg8::Gemm g{MIXb, (const bf16*)(P.ws + WS_WMO), M, D, D, 0}; pg8::StaticOrder S; S.init(M, D, F.G, gc, WG_OUT);
        pg8::EpiResid<1> E{nullptr, Xb, Xb, nullptr, mods + 5 * D, NMOD, 1.0f, SS2};
        pg8::gemm_phase<pg8::EpiResid<1>, pg8::StaticOrder, PG8_ALIGN, PG8_SP2>(F.lds + RING_OFF, g, S, E);
        if (BOTH(8)) LOCAL_BAR();
    }
    if (IN(9)) { const int gc = GEMM_C();
        pg8::Gemm g{Xb, (const bf16*)(P.ws + WS_W2I), M, 2 * FF, D, (size_t)2 * FF * D * 2}; pg8::StaticOrder S; S.init(M, 2 * FF, F.G, gc, WG_IN);
        pg8::EpiSwiGLU<true> E{ZH, FF, (LAS float*)(F.lds + pg8::EPT_OFF), 0, {}};
        { const float* b2i = (const float*)(P.ws + WS_B2I); const int h = F.tid >> 8, e = F.tid & 255;
#pragma unroll
          for (int k = 0; k < 6; ++k) { pg8::Unit u; float v = 1.0f;
              if (S.next(k, u)) v = h == 0 ? SS2[u.pm * 256 + e] : b2i[(u.pm >= 32 ? 2 * FF : 0) + u.pn * 256 + e];
              E.tv.v[k] = v; }
          int nu = 0; { pg8::Unit u; while (nu < 6 && S.next(nu, u)) ++nu; } E.npairs = 2 * nu; }
        pg8::gemm_phase<pg8::EpiSwiGLU<true>, pg8::StaticOrder, PG8_ALIGN, PG8_SP2>(F.lds + RING_OFF, g, S, E);
        if (BOTH(9)) LOCAL_BAR();
    }
    if (IN(10)) { const int gc = GEMM_C();
        pg8::Gemm g{ZH, (const bf16*)(P.ws + WS_W2O), M, D, FF, 0}; pg8::StaticOrder S; S.init(M, D, F.G, gc, WG_OUT);
        pg8::EpiResid<2> E{nullptr, Xb, nullptr, P.out, mods + 8 * D, NMOD, 0.5f, nullptr};
        pg8::gemm_phase<pg8::EpiResid<2>, pg8::StaticOrder, PG8_ALIGN, PG8_SP2>(F.lds + RING_OFF, g, S, E);
    }
#undef IN
#undef BOTH
}

extern "C" void kernel_launch(void* const* d_in, const int* in_sizes, int n_in, void* d_out, int out_size, void* d_ws, size_t ws_size, hipStream_t stream) {
    static int grid = 0;
    if (grid == 0) {
        if (n_in != 16 || in_sizes[0] != M * D || out_size != M * D || ws_size < WS_END) { fprintf(stderr, "kernel_launch: unexpected shapes (n_in %d, in0 %d, out %d, ws %zu)\n", n_in, n_in > 0 ? in_sizes[0] : -1, out_size, ws_size); grid = -1; return; }
        int dev = 0, cus = 0, per_cu = 0;
        if (hipGetDevice(&dev) != hipSuccess || hipDeviceGetAttribute(&cus, hipDeviceAttributeMultiprocessorCount, dev) != hipSuccess) { grid = -1; return; }
        if (hipFuncSetAttribute((const void*)mk_fwd, hipFuncAttributeMaxDynamicSharedMemorySize, LDS_BYTES) != hipSuccess) { fprintf(stderr, "kernel_launch: hipFuncSetAttribute failed\n"); grid = -1; return; }
        if (hipOccupancyMaxActiveBlocksPerMultiprocessor(&per_cu, (const void*)mk_fwd, NWAVES * 64, LDS_BYTES) != hipSuccess || per_cu < 1) { fprintf(stderr, "kernel_launch: occupancy query says %d blocks per CU\n", per_cu); per_cu = 1; }
        (void)hipGetLastError();
        grid = cus;
        if (grid > 256) grid = 256;
        if ((M / 256) * (2 * FF / 256) > 6 * grid || (M / 256) * (DIN / 256) > 4 * grid) { fprintf(stderr, "kernel_launch: %d CUs: the epilogue tables hold at most 6 (FFN-in) / 4 (mixer-in) units per workgroup\n", grid); grid = -1; return; }
    }
    if (grid < 0) return;
    (void)hipMemsetAsync((char*)d_ws + WS_CTL, 0, CTL_ZERO_BYTES, stream);
    Args a{};
    const float** pp = (const float**)&a.p;
    for (int i = 0; i < 16; ++i) pp[i] = (const float*)d_in[i];
    a.p.out = (float*)d_out; a.p.ws = (unsigned char*)d_ws;
    if (N_LAUNCHES == 1) { a.ph_lo = 0; a.ph_hi = PER_PHASE; a.li = 0; hipLaunchKernelGGL(mk_fwd, dim3(grid), dim3(NWAVES * 64), LDS_BYTES, stream, a); }
    else for (int li = 0; li < PER_PHASE; ++li) { a.ph_lo = li; a.ph_hi = li + 1; a.li = li; hipLaunchKernelGGL(mk_fwd, dim3(grid), dim3(NWAVES * 64), LDS_BYTES, stream, a); }
}
```
